# Optimizing an MI355X kernel written in HIP

```python
import math
import jax, jax.numpy as jnp
from jax import lax
import numpy as np


D_MODEL = 2048
BATCH = 1
SEQ = 16384
DEPTH = 2

GRID_W = 64
CTX_LEN = 256
HEAD_DIM = 128
DA_HEADS = 4
NA_HEADS = 8
DA_WIDTH = DA_HEADS * 2 * HEAD_DIM
NA_WIDTH = NA_HEADS * HEAD_DIM
MIX_DIM = DA_WIDTH + NA_WIDTH
IN_DIM = 3 * DA_WIDTH + 3 * NA_WIDTH
IN_SPLITS = [DA_WIDTH, 2 * DA_WIDTH, 3 * DA_WIDTH, 3 * DA_WIDTH + NA_WIDTH, 3 * DA_WIDTH + 2 * NA_WIDTH]
NA_KH = 8
NA_KW = 16
D_FF = 5632
CONV_W = 3
ROPE_THETA = 10000.0
Q_BLOCK = 128
LN_EPS = 1e-5
ATTN_SCALE = HEAD_DIM ** -0.5
N_MOD = 6

kernel_name = 'hybrid_diffattn_natten_convffn_deepnorm'


def _layernorm(x, g, b):
    xf = x.astype(jnp.float32)
    mu = jnp.mean(xf, axis=-1, keepdims=True)
    var = jnp.mean(jnp.square(xf - mu), axis=-1, keepdims=True)
    y = (xf - mu) * lax.rsqrt(var + LN_EPS)
    return (y * g.astype(jnp.float32) + b.astype(jnp.float32)).astype(x.dtype)


def _rmsnorm(x, g):
    xf = x.astype(jnp.float32)
    y = xf * lax.rsqrt(jnp.mean(jnp.square(xf), axis=-1, keepdims=True) + LN_EPS)
    return (y * g.astype(jnp.float32)).astype(x.dtype)


def _to_blocks(t, qb):
    b, l = t.shape[:2]
    return jnp.moveaxis(t.reshape((b, l // qb, qb) + t.shape[2:]), 1, 0)


def _from_blocks(t):
    nb, b, qb = t.shape[:3]
    return jnp.moveaxis(t, 0, 1).reshape((b, nb * qb) + t.shape[3:])


def _axial_rope_tables(L):
    t = jnp.arange(L, dtype=jnp.int32)
    pos_r = (t // GRID_W).astype(jnp.float32)
    pos_c = (t % GRID_W).astype(jnp.float32)
    half = HEAD_DIM // 2
    inv_freq = 1.0 / (ROPE_THETA ** (jnp.arange(0, half, 2, dtype=jnp.float32) / half))
    ar = pos_r[:, None] * inv_freq[None, :]
    ac = pos_c[:, None] * inv_freq[None, :]
    ang = jnp.concatenate([ar, ar, ac, ac], axis=-1)
    return jnp.cos(ang), jnp.sin(ang)


def _apply_rope(x, cos, sin):
    cos = cos[:, None, None, :].astype(x.dtype)
    sin = sin[:, None, None, :].astype(x.dtype)
    a1, a2, b1, b2 = jnp.split(x, 4, axis=-1)
    rot = jnp.concatenate([-a2, a1, -b2, b1], axis=-1)
    return x * cos + rot * sin


def _na_neighbours(L):
    rows = L // GRID_W
    kh = min(NA_KH, rows)
    t = jnp.arange(L, dtype=jnp.int32)
    r = t // GRID_W
    col = t % GRID_W
    rs = jnp.clip(r - kh // 2, 0, rows - kh)
    cs = jnp.clip(col - NA_KW // 2, 0, GRID_W - NA_KW)
    kr = rs[:, None, None] + jnp.arange(kh, dtype=jnp.int32)[None, :, None]
    kc = cs[:, None, None] + jnp.arange(NA_KW, dtype=jnp.int32)[None, None, :]
    shape = (L, kh, NA_KW)
    idx = jnp.broadcast_to(kr * GRID_W + kc, shape).reshape(L, kh * NA_KW)
    br = jnp.broadcast_to(kr - r[:, None, None] + (NA_KH - 1), shape).reshape(L, kh * NA_KW)
    bc = jnp.broadcast_to(kc - col[:, None, None] + (NA_KW - 1), shape).reshape(L, kh * NA_KW)
    return idx, br, bc


def _project(h, w_in):
    b, l, _ = h.shape
    q_da, k_da, v_da, q_na, k_na, v_na = jnp.split(h @ w_in, IN_SPLITS, axis=-1)
    return (q_da.reshape(b, l, DA_HEADS, 2, HEAD_DIM),
            k_da.reshape(b, l, DA_HEADS, 2, HEAD_DIM),
            v_da.reshape(b, l, DA_HEADS, 2 * HEAD_DIM),
            q_na.reshape(b, l, NA_HEADS, HEAD_DIM),
            k_na.reshape(b, l, NA_HEADS, HEAD_DIM),
            v_na.reshape(b, l, NA_HEADS, HEAD_DIM))


def _diff_weights(q, k, lam):
    s = jnp.einsum('bqhcd,bkhcd->bhcqk', q, k).astype(jnp.float32) * ATTN_SCALE
    p = jax.nn.softmax(s, axis=-1)
    return p[:, :, 0] - lam * p[:, :, 1]


def _diff_attention_latent(q, k_all, v_all, lam):
    def block(qb):
        w = _diff_weights(qb, k_all, lam).astype(v_all.dtype)
        return jnp.einsum('bhqk,bkhe->bqhe', w, v_all)
    return _from_blocks(lax.map(block, _to_blocks(q, Q_BLOCK)))


def _na_latent(q, k_lat, v_lat, k_ctx, v_ctx, rpb, idx, br, bc):
    nk = idx.shape[-1]
    nb = idx.shape[0] // Q_BLOCK

    def block(args):
        qb, ib, rb, cb = args
        kg = jnp.take(k_lat, ib, axis=1)
        vg = jnp.take(v_lat, ib, axis=1)
        s_loc = jnp.einsum('bqhd,bqnhd->bhqn', qb, kg).astype(jnp.float32) * ATTN_SCALE
        s_loc = s_loc + rpb[:, rb, cb].astype(jnp.float32)[None]
        s_ctx = jnp.einsum('bqhd,bkhd->bhqk', qb, k_ctx).astype(jnp.float32) * ATTN_SCALE
        p = jax.nn.softmax(jnp.concatenate([s_loc, s_ctx], axis=-1), axis=-1).astype(qb.dtype)
        return (jnp.einsum('bhqn,bqnhd->bqhd', p[..., :nk], vg)
                + jnp.einsum('bhqk,bkhd->bqhd', p[..., nk:], v_ctx))

    xs = (_to_blocks(q, Q_BLOCK), idx.reshape(nb, Q_BLOCK, nk),
          br.reshape(nb, Q_BLOCK, nk), bc.reshape(nb, Q_BLOCK, nk))
    return _from_blocks(lax.map(block, xs))


def _dense_attention(q, k, v):
    s = jnp.einsum('bqhd,bkhd->bhqk', q, k).astype(jnp.float32) * ATTN_SCALE
    p = jax.nn.softmax(s, axis=-1).astype(v.dtype)
    return jnp.einsum('bhqk,bkhd->bqhd', p, v)


def _mixer(h, hc, w_in, lam_vec, subln_g, rpb, w_o, lambda_init, cos, sin, nbr, with_ctx_out):
    b, l, _ = h.shape
    qd, kd, vd, qn, kn, vn = _project(h, w_in)
    qdc, kdc, vdc, qnc, knc, vnc = _project(hc, w_in)
    lv = lam_vec.astype(jnp.float32)
    lam = jnp.exp(jnp.sum(lv[0] * lv[1])) - jnp.exp(jnp.sum(lv[2] * lv[3])) + lambda_init
    qd = _apply_rope(qd, cos, sin)
    kd = _apply_rope(kd, cos, sin)
    k_all = jnp.concatenate([kdc, kd], axis=1)
    v_all = jnp.concatenate([vdc, vd], axis=1)
    od = _diff_attention_latent(qd, k_all, v_all, lam)
    od = (_rmsnorm(od, subln_g) * (1.0 - lambda_init)).reshape(b, l, DA_WIDTH)
    on = _na_latent(qn, kn, vn, knc, vnc, rpb, *nbr).reshape(b, l, NA_WIDTH)
    y = jnp.concatenate([od, on], axis=-1) @ w_o
    if not with_ctx_out:
        return y, None
    lc = hc.shape[1]
    wdc = _diff_weights(qdc, kdc, lam).astype(vdc.dtype)
    odc = jnp.einsum('bhqk,bkhe->bqhe', wdc, vdc)
    odc = (_rmsnorm(odc, subln_g) * (1.0 - lambda_init)).reshape(b, lc, DA_WIDTH)
    onc = _dense_attention(qnc, knc, vnc).reshape(b, lc, NA_WIDTH)
    yc = jnp.concatenate([odc, onc], axis=-1) @ w_o
    return y, yc


def _dwconv3(x, w, bias):
    xp = jnp.pad(x, ((0, 0), (1, 1), (0, 0)))
    return xp[:, :-2] * w[0] + xp[:, 1:-1] * w[1] + xp[:, 2:] * w[2] + bias


def _conv_ffn(h, w_up, conv_w, conv_b, w_down):
    g, u = jnp.split(h @ w_up, 2, axis=-1)
    g = _dwconv3(g, conv_w, conv_b)
    return (jax.nn.silu(g) * u) @ w_down


def setup_inputs(seed: int = 0) -> dict:
    key = jax.random.key(seed)
    ks = jax.random.split(key, 24)
    beta = (8.0 * DEPTH) ** -0.25
    f32 = jnp.float32

    def nrm(k, shape, scale):
        return jax.random.normal(k, shape, f32) * scale

    return {
        'x': nrm(ks[0], (BATCH, SEQ, D_MODEL), 1.0),
        'c': nrm(ks[1], (BATCH, D_MODEL), 1.0),
        'ctx': nrm(ks[2], (BATCH, CTX_LEN, D_MODEL), 1.0),
        'c_ctx': nrm(ks[3], (D_MODEL,), 1.0),
        'w_ada': nrm(ks[4], (DEPTH, D_MODEL, N_MOD * D_MODEL), 0.25 * D_MODEL ** -0.5),
        'b_ada': nrm(ks[5], (DEPTH, N_MOD * D_MODEL), 0.01),
        'w_in': nrm(ks[6], (DEPTH, D_MODEL, IN_DIM), D_MODEL ** -0.5),
        'da_lambda': nrm(ks[7], (DEPTH, 4, HEAD_DIM), 0.1),
        'da_subln': 1.0 + nrm(ks[8], (DEPTH, 2 * HEAD_DIM), 0.02),
        'na_rpb': nrm(ks[9], (DEPTH, NA_HEADS, 2 * NA_KH - 1, 2 * NA_KW - 1), 0.1),
        'w_o': nrm(ks[10], (DEPTH, MIX_DIM, D_MODEL), beta * MIX_DIM ** -0.5),
        'ln1_g': 1.0 + nrm(ks[11], (DEPTH, D_MODEL), 0.02),
        'ln1_b': nrm(ks[12], (DEPTH, D_MODEL), 0.02),
        'w_up': nrm(ks[13], (DEPTH, D_MODEL, 2 * D_FF), D_MODEL ** -0.5),
        'conv_w': nrm(ks[14], (DEPTH, CONV_W, D_FF), CONV_W ** -0.5),
        'conv_b': nrm(ks[15], (DEPTH, D_FF), 0.02),
        'w_down': nrm(ks[16], (DEPTH, D_FF, D_MODEL), beta * D_FF ** -0.5),
        'ln2_g': 1.0 + nrm(ks[17], (DEPTH, D_MODEL), 0.02),
        'ln2_b': nrm(ks[18], (DEPTH, D_MODEL), 0.02),
    }


def reference(x, c, ctx, c_ctx, w_ada, b_ada, w_in, da_lambda, da_subln, na_rpb, w_o,
              ln1_g, ln1_b, w_up, conv_w, conv_b, w_down, ln2_g, ln2_b):
    L = x.shape[1]
    alpha = (2.0 * DEPTH) ** 0.25
    cos, sin = _axial_rope_tables(L)
    nbr = _na_neighbours(L)
    xc = ctx
    for l in range(DEPTH):
        last = l == DEPTH - 1
        lambda_init = 0.8 - 0.6 * math.exp(-0.3 * l)
        mod = (jax.nn.silu(c) @ w_ada[l] + b_ada[l])[:, None, :]
        mod_c = jax.nn.silu(c_ctx) @ w_ada[l] + b_ada[l]
        sh_a, sc_a, g_a, sh_m, sc_m, g_m = jnp.split(mod, N_MOD, axis=-1)
        shc_a, scc_a, gc_a, shc_m, scc_m, gc_m = jnp.split(mod_c, N_MOD, axis=-1)
        y, yc = _mixer(x * (1.0 + sc_a) + sh_a, xc * (1.0 + scc_a) + shc_a,
                       w_in[l], da_lambda[l], da_subln[l], na_rpb[l], w_o[l],
                       lambda_init, cos, sin, nbr, not last)
        x = _layernorm(alpha * x + g_a * y, ln1_g[l], ln1_b[l])
        f = _conv_ffn(x * (1.0 + sc_m) + sh_m, w_up[l], conv_w[l], conv_b[l], w_down[l])
        x = _layernorm(alpha * x + g_m * f, ln2_g[l], ln2_b[l])
        if not last:
            xc = _layernorm(alpha * xc + gc_a * yc, ln1_g[l], ln1_b[l])
            fc = _conv_ffn(xc * (1.0 + scc_m) + shc_m, w_up[l], conv_w[l], conv_b[l], w_down[l])
            xc = _layernorm(alpha * xc + gc_m * fc, ln2_g[l], ln2_b[l])
    return x
```

```cpp
#include <hip/hip_runtime.h>
#include <hip/hip_bf16.h>
#include <hip/hip_cooperative_groups.h>
#include <cstdio>
#include <cstdint>
#include <cmath>
namespace cg = cooperative_groups;
namespace pg8 {
#define PG8_LAS __attribute__((address_space(3)))
typedef unsigned short bf16_t;
typedef short bf16x8 __attribute__((ext_vector_type(8)));
typedef float f32x4 __attribute__((ext_vector_type(4)));
typedef unsigned u32x4 __attribute__((ext_vector_type(4)));
constexpr int BM = 256, BK = 64, HALF = 128, HTB = HALF * BK * 2  , STAGE_BYTES = 8 * HTB, NXCD = 8, WGM = 8;

__host__ __device__ __forceinline__ int lds_byte(int r, int c) { const int st = (r >> 4) * 2 + (c >> 5), rr = r & 15, cc = c & 31, ob = rr * 64 + cc * 2; return st * 1024 + (ob ^ (((ob >> 9) & 1) << 5)); }
__host__ __device__ __forceinline__ void stage_rc(int b, int& R, int& C) { const int st = b / 1024, sb = b % 1024, swz = sb ^ (((sb >> 9) & 1) << 5); R = (st >> 1) * 16 + swz / 64; C = (st & 1) * 32 + (swz % 64) / 2; }
__host__ __device__ __forceinline__ int perm32(int rho) { const int n = rho >> 4, i = rho & 15; return 8 * (i >> 2) + 4 * n + (i & 3); }

struct Unit { int pm, pn; };
struct Gemm { const bf16_t* A; const bf16_t* Bt; int M, N, K, ld; };

struct StaticOrder {
    int nM, nN, nwg, G, c;
    __host__ __device__ void init(int M, int N, int G_, int c_) { nM = M / BM; nN = N / BM; nwg = nM * nN; G = G_; c = c_; }
    __host__ __device__ bool next(int i, Unit& u) const {
        const long L = (long)i * G + c; if (L >= nwg) return false;
        int wgid = (int)L; { const int q = nwg / NXCD, r = nwg % NXCD, xcd = wgid % NXCD, off = wgid / NXCD; wgid = (xcd < r ? xcd * (q + 1) : r * (q + 1) + (xcd - r) * q) + off; }
        const int nig = WGM * nN, gid = wgid / nig, fm = gid * WGM, gsz = (nM - fm) < WGM ? (nM - fm) : WGM;
        u.pm = fm + ((wgid % nig) % gsz); u.pn = (wgid % nig) / gsz; return true;
    }
    __device__ __forceinline__ void a_ready(const Unit&) const {}
    __device__ __forceinline__ void done(const Unit&) const {}
};

__device__ __forceinline__ unsigned cvt_pk_bf16(float lo, float hi) { unsigned r; asm volatile("v_cvt_pk_bf16_f32 %0, %1, %2" : "=v"(r) : "v"(lo), "v"(hi)); return r; }
typedef float f32x2 __attribute__((ext_vector_type(2)));
struct EpiBf16 {
    static constexpr bool PERM = true, AFTER_DRAIN = false;
    bf16_t* O; int ldc;
    __device__ __forceinline__ void operator()(const f32x4 (&acc)[2][2][4][2], const Unit& u, int wr, int wc, int fr, int fq) const {
        const int row0 = u.pm * BM + wr * 64 + fr; const int col0 = u.pn * BM + wc * 32 + 8 * fq;
#pragma unroll
        for (int ai = 0; ai < 2; ++ai)
#pragma unroll
            for (int m = 0; m < 4; ++m) { bf16_t* rowp = O + (size_t)(row0 + ai * HALF + m * 16) * ldc + col0;
#pragma unroll
                for (int bj = 0; bj < 2; ++bj) { const f32x4 v0 = acc[ai][bj][m][0], v1 = acc[ai][bj][m][1];
                    u32x4 w; w.x = cvt_pk_bf16(v0[0], v0[1]); w.y = cvt_pk_bf16(v0[2], v0[3]); w.z = cvt_pk_bf16(v1[0], v1[1]); w.w = cvt_pk_bf16(v1[2], v1[3]);
                    *(u32x4*)(rowp + bj * HALF) = w; } }
    }
    __device__ __forceinline__ void fused(f32x4 (&)[2][2][4][2], const Unit&, int, int, int, int, PG8_LAS unsigned char*, int, int) const {}
};

struct OneUnit {
    int pn; bool has;
    __device__ bool next(int i, Unit& u) const { if (i != 0 || !has) return false; u.pm = 0; u.pn = pn; return true; }
    __device__ __forceinline__ void a_ready(const Unit&) const {}
    __device__ __forceinline__ void done(const Unit&) const {}
};
struct EpiF32 {
    static constexpr bool PERM = true, AFTER_DRAIN = false;
    float* slab; int N, split;
    __device__ __forceinline__ void operator()(const f32x4 (&acc)[2][2][4][2], const Unit& u, int wr, int wc, int fr, int fq) const {
        const int row0 = wr * 64 + fr, col0 = u.pn * BM + wc * 32 + 8 * fq;
        float* sl = slab + (size_t)split * 256 * N;
#pragma unroll
        for (int ai = 0; ai < 2; ++ai)
#pragma unroll
            for (int m = 0; m < 4; ++m) { float* rowp = sl + (size_t)(row0 + ai * HALF + m * 16) * N + col0;
#pragma unroll
                for (int bj = 0; bj < 2; ++bj) { *(f32x4*)(rowp + bj * HALF) = acc[ai][bj][m][0]; *(f32x4*)(rowp + bj * HALF + 4) = acc[ai][bj][m][1]; } }
    }
    __device__ __forceinline__ void fused(f32x4 (&)[2][2][4][2], const Unit&, int, int, int, int, PG8_LAS unsigned char*, int, int) const {}
};

struct EpiProj {
    static constexpr bool PERM = true, AFTER_DRAIN = false;
    bf16_t* O; int ldc; const float* tab;
    __device__ __forceinline__ void operator()(const f32x4 (&acc)[2][2][4][2], const Unit& u, int wr_, int wc_, int fr_, int fq_) const {
        int t_ = threadIdx.x; asm volatile("" : "+v"(t_));
        const int wid_ = t_ >> 6, lane_ = t_ & 63, wr = wid_ >> 2, wc = wid_ & 3, fr = lane_ & 15, fq = lane_ >> 4; (void)wr_; (void)wc_; (void)fr_; (void)fq_;
        const int row0 = u.pm * BM + wr * 64 + fr;
        if (u.pn >= 8) {
            const int col0 = u.pn * BM + wc * 32 + 8 * fq;
#pragma unroll
            for (int ai = 0; ai < 2; ++ai)
#pragma unroll
                for (int m = 0; m < 4; ++m) { bf16_t* rowp = O + (size_t)(row0 + ai * HALF + m * 16) * ldc + col0;
#pragma unroll
                    for (int bj = 0; bj < 2; ++bj) { const f32x4 v0 = acc[ai][bj][m][0], v1 = acc[ai][bj][m][1];
                        u32x4 w; w.x = cvt_pk_bf16(v0[0], v0[1]); w.y = cvt_pk_bf16(v0[2], v0[3]); w.z = cvt_pk_bf16(v1[0], v1[1]); w.w = cvt_pk_bf16(v1[2], v1[3]);
                        *(u32x4*)(rowp + bj * HALF) = w; } }
            return;
        }
        typedef unsigned u32x2 __attribute__((ext_vector_type(2)));
        const int p = wc >> 1, i0 = ((wc & 1) * 4 + fq) * 4; const bool rope = u.pm >= 1;
#pragma unroll
        for (int ai = 0; ai < 2; ++ai)
#pragma unroll
            for (int m = 0; m < 4; ++m) { const int row = row0 + ai * HALF + m * 16; const int t = row - 256;
                f32x4 c01 = {1.f, 0.f, 1.f, 0.f}, c23 = {1.f, 0.f, 1.f, 0.f};
                if (rope) { const float* tb = tab + ((size_t)(p ? 256 + (t & 63) : (t >> 6)) * 32 + i0) * 2; c01 = *(const f32x4*)tb; c23 = *(const f32x4*)(tb + 4); }
                bf16_t* rowp = O + (size_t)row * ldc + u.pn * BM + p * 64 + i0;
#pragma unroll
                for (int bj = 0; bj < 2; ++bj) { const f32x4 x1 = acc[ai][bj][m][0], x2 = acc[ai][bj][m][1];
                    u32x2 a, b;
                    a.x = cvt_pk_bf16(x1[0] * c01[0] - x2[0] * c01[1], x1[1] * c01[2] - x2[1] * c01[3]); a.y = cvt_pk_bf16(x1[2] * c23[0] - x2[2] * c23[1], x1[3] * c23[2] - x2[3] * c23[3]);
                    b.x = cvt_pk_bf16(x2[0] * c01[0] + x1[0] * c01[1], x2[1] * c01[2] + x1[1] * c01[3]); b.y = cvt_pk_bf16(x2[2] * c23[0] + x1[2] * c23[1], x2[3] * c23[2] + x1[3] * c23[3]);
                    *(u32x2*)(rowp + bj * HALF) = a; *(u32x2*)(rowp + bj * HALF + 32) = b; } }
    }
    __device__ __forceinline__ void fused(f32x4 (&)[2][2][4][2], const Unit&, int, int, int, int, PG8_LAS unsigned char*, int, int) const {}
};
template <class Epi, class Sched, bool ALIGN_EPI = false, bool SP2 = false>
__device__ __forceinline__ void gemm_phase(PG8_LAS unsigned char* lds, const Gemm g, const Sched& S, const Epi& E) {
    int tid = threadIdx.x; asm volatile("" : "+v"(tid));
    const int wid = __builtin_amdgcn_readfirstlane(tid >> 6), lane = tid & 63, wr = wid >> 2, wc = wid & 3, fr = lane & 15, fq = lane >> 4;
    const int K = g.ld, nt = g.K / BK;
    unsigned voffA[2], voffB[2];
#pragma unroll
    for (int i = 0; i < 2; ++i) { int R, C; stage_rc(tid * 16 + i * 8192, R, C); const int Rb = Epi::PERM ? ((R & ~31) + perm32(R & 31)) : R;
        voffA[i] = (unsigned)(R * K + C) * 2u; voffB[i] = (unsigned)(Rb * K + C) * 2u; }
    const size_t kstep = (size_t)(BK * 2);
    const size_t hstep = (size_t)HALF * K * 2;
    const size_t tstep = 2 * hstep;
    const unsigned ldsw = (unsigned)wid * 1024u;
    const int aoff = lds_byte(wr * 64 + fr, fq * 8), boff = lds_byte(wc * 32 + fr, fq * 8);
#define PG8_SA(b, h) (((b) * 2 + (h)) * HTB)
#define PG8_SB(b, h) ((4 + (b) * 2 + (h)) * HTB)
#define PG8_STAGE(bufoff, gbase, voff) do { _Pragma("unroll") for (int _i = 0; _i < 2; ++_i) \
        __builtin_amdgcn_global_load_lds((const unsigned*)((const char*)(gbase) + (voff)[_i]), (PG8_LAS unsigned*)(lds + (bufoff) + ldsw + _i * 8192), 16, 0, 0); } while (0)
#define PG8_LDA(dst, b, h) do { _Pragma("unroll") for (int m = 0; m < 4; ++m) _Pragma("unroll") for (int k = 0; k < 2; ++k) dst[m][k] = *(const PG8_LAS bf16x8*)(lds + PG8_SA(b, h) + aoff + m * 2048 + k * 1024); } while (0)
#define PG8_LDB(dst, b, h) do { _Pragma("unroll") for (int n = 0; n < 2; ++n) _Pragma("unroll") for (int k = 0; k < 2; ++k) dst[n][k] = *(const PG8_LAS bf16x8*)(lds + PG8_SB(b, h) + boff + n * 2048 + k * 1024); } while (0)
#define PG8_MMA(ai, bj, At, Bt) do { __builtin_amdgcn_s_setprio(1); _Pragma("unroll") for (int m = 0; m < 4; ++m) _Pragma("unroll") for (int n = 0; n < 2; ++n) _Pragma("unroll") for (int k = 0; k < 2; ++k) \
        acc[ai][bj][m][n] = __builtin_amdgcn_mfma_f32_16x16x32_bf16(Bt[n][k], At[m][k], acc[ai][bj][m][n], 0, 0, 0); __builtin_amdgcn_s_setprio(0); } while (0)
#define PG8_WAIT_V(n) asm volatile("s_waitcnt vmcnt(" #n ")" ::: "memory")
#define PG8_WAIT_L(n) asm volatile("s_waitcnt lgkmcnt(" #n ")" ::: "memory")
#define PG8_BAR __builtin_amdgcn_s_barrier()
#define PG8_SCHED __builtin_amdgcn_sched_barrier(0)
    Unit cur, nxt; int ui = 0;
    if (!S.next(0, cur)) return;
    f32x4 acc[2][2][4][2];
#pragma unroll
    for (int a = 0; a < 2; ++a)
#pragma unroll
        for (int b = 0; b < 2; ++b)
#pragma unroll
            for (int m = 0; m < 4; ++m)
#pragma unroll
                for (int n = 0; n < 2; ++n) acc[a][b][m][n] = (f32x4){0.f, 0.f, 0.f, 0.f};
    bf16x8 At[4][2], B0[2][2], B1[2][2];
    const char* cA = (const char*)g.A + (size_t)cur.pm * tstep; const char* cB = (const char*)g.Bt + (size_t)cur.pn * tstep;
    S.a_ready(cur);
    if constexpr (SP2) {
        PG8_STAGE(PG8_SB(0, 0), cB, voffB); PG8_STAGE(PG8_SB(0, 1), cB + hstep, voffB); PG8_STAGE(PG8_SA(0, 0), cA, voffA); PG8_STAGE(PG8_SA(0, 1), cA + hstep, voffA);
        if (wr == 1) PG8_BAR;
        PG8_WAIT_V(2); PG8_BAR;
        PG8_STAGE(PG8_SB(1, 0), cB + kstep, voffB); PG8_STAGE(PG8_SA(1, 0), cA + kstep, voffA); PG8_STAGE(PG8_SB(1, 1), cB + hstep + kstep, voffB);
        PG8_WAIT_V(6); PG8_BAR;
    } else {
        PG8_STAGE(PG8_SB(0, 0), cB, voffB); PG8_STAGE(PG8_SA(0, 0), cA, voffA); PG8_STAGE(PG8_SB(0, 1), cB + hstep, voffB); PG8_STAGE(PG8_SA(0, 1), cA + hstep, voffA);
        if (wr == 1) PG8_BAR;
        PG8_WAIT_V(4); PG8_BAR;
        PG8_STAGE(PG8_SB(1, 0), cB + kstep, voffB); PG8_STAGE(PG8_SA(1, 0), cA + kstep, voffA); PG8_STAGE(PG8_SB(1, 1), cB + hstep + kstep, voffB);
        PG8_WAIT_V(6); PG8_BAR;
    }
    for (;;) {
        const bool has_next = S.next(ui + 1, nxt);
        const char* nA = has_next ? (const char*)g.A + (size_t)nxt.pm * tstep : cA; const char* nB = has_next ? (const char*)g.Bt + (size_t)nxt.pn * tstep : cB;
        for (int t = 0; t < nt; t += 2) {
            const bool last = (t == nt - 2);
            const char* a1 = cA + (size_t)(t + 1) * kstep;
            const char* a2 = last ? nA : cA + (size_t)(t + 2) * kstep; const char* b2 = last ? nB : cB + (size_t)(t + 2) * kstep;
            const char* a3 = a2 + kstep; const char* b3 = b2 + kstep;
            if (last && has_next) S.a_ready(nxt);
            if constexpr (SP2) {
            PG8_LDB(B0, 0, 0); PG8_LDB(B1, 0, 1); PG8_SCHED; PG8_LDA(At, 0, 0); PG8_STAGE(PG8_SA(1, 1), a1 + hstep, voffA);
            PG8_WAIT_V(8); PG8_WAIT_L(0); PG8_BAR; PG8_MMA(0, 0, At, B0); PG8_MMA(0, 1, At, B1); PG8_BAR; PG8_SCHED;
            PG8_LDA(At, 0, 1); PG8_STAGE(PG8_SB(0, 0), b2, voffB); PG8_STAGE(PG8_SB(0, 1), b2 + hstep, voffB); PG8_STAGE(PG8_SA(0, 0), a2, voffA);
            PG8_WAIT_V(8); PG8_WAIT_L(0); PG8_BAR; PG8_MMA(1, 0, At, B0); PG8_MMA(1, 1, At, B1); PG8_BAR; PG8_SCHED;
            PG8_LDB(B0, 1, 0); PG8_LDB(B1, 1, 1); PG8_SCHED; PG8_LDA(At, 1, 0); PG8_STAGE(PG8_SA(0, 1), a2 + hstep, voffA);
            PG8_WAIT_V(8); PG8_WAIT_L(0); PG8_BAR; PG8_MMA(0, 0, At, B0); PG8_MMA(0, 1, At, B1); PG8_BAR; PG8_SCHED;
            PG8_LDA(At, 1, 1); PG8_STAGE(PG8_SB(1, 0), b3, voffB); PG8_STAGE(PG8_SB(1, 1), b3 + hstep, voffB); PG8_STAGE(PG8_SA(1, 0), a3, voffA);
            PG8_WAIT_V(8); PG8_WAIT_L(0); PG8_BAR; PG8_MMA(1, 0, At, B0); PG8_MMA(1, 1, At, B1); PG8_BAR; PG8_SCHED;
            } else {
            PG8_LDB(B0, 0, 0); PG8_SCHED; PG8_LDA(At, 0, 0); PG8_STAGE(PG8_SA(1, 1), a1 + hstep, voffA);
            PG8_WAIT_L(8); PG8_BAR; PG8_WAIT_L(0); PG8_MMA(0, 0, At, B0); PG8_BAR; PG8_SCHED;
            PG8_LDB(B1, 0, 1); PG8_STAGE(PG8_SB(0, 0), b2, voffB);
            PG8_BAR; PG8_WAIT_L(0); PG8_MMA(0, 1, At, B1); PG8_BAR;
            PG8_LDA(At, 0, 1); PG8_STAGE(PG8_SA(0, 0), a2, voffA);
            PG8_BAR; PG8_WAIT_L(0); PG8_MMA(1, 0, At, B0); PG8_BAR; PG8_SCHED;
            PG8_STAGE(PG8_SB(0, 1), b2 + hstep, voffB);
            PG8_WAIT_V(6); PG8_BAR; PG8_MMA(1, 1, At, B1); PG8_BAR;
            PG8_LDB(B0, 1, 0); PG8_SCHED; PG8_LDA(At, 1, 0); PG8_STAGE(PG8_SA(0, 1), a2 + hstep, voffA);
            PG8_WAIT_L(8); PG8_BAR; PG8_WAIT_L(0); PG8_MMA(0, 0, At, B0); PG8_BAR; PG8_SCHED;
            PG8_LDB(B1, 1, 1); PG8_STAGE(PG8_SB(1, 0), b3, voffB);
            PG8_BAR; PG8_WAIT_L(0); PG8_MMA(0, 1, At, B1); PG8_BAR;
            PG8_LDA(At, 1, 1); PG8_STAGE(PG8_SA(1, 0), a3, voffA);
            PG8_BAR; PG8_WAIT_L(0); PG8_MMA(1, 0, At, B0); PG8_BAR; PG8_SCHED;
            PG8_STAGE(PG8_SB(1, 1), b3 + hstep, voffB);
            PG8_WAIT_V(6); PG8_BAR; PG8_MMA(1, 1, At, B1); PG8_BAR;
            }
        }
        if constexpr (ALIGN_EPI) { if (wr == 0) PG8_BAR; }
        if constexpr (!Epi::AFTER_DRAIN) { E(acc, cur, wr, wc, fr, fq); S.done(cur); }
        if (!has_next) break;
#pragma unroll
        for (int a = 0; a < 2; ++a)
#pragma unroll
            for (int b = 0; b < 2; ++b)
#pragma unroll
                for (int m = 0; m < 4; ++m)
#pragma unroll
                    for (int n = 0; n < 2; ++n) acc[a][b][m][n] = (f32x4){0.f, 0.f, 0.f, 0.f};
        cur = nxt; cA = nA; cB = nB; ++ui;
        if constexpr (ALIGN_EPI) { if (wr == 1) PG8_BAR; }
    }
    PG8_WAIT_V(0);
    if constexpr (!ALIGN_EPI) { if (wr == 0) PG8_BAR; }
    PG8_BAR;
    if constexpr (Epi::AFTER_DRAIN) { E.fused(acc, cur, wr, wc, fr, fq, lds, wid, lane); S.done(cur); }
#undef PG8_SA
#undef PG8_SB
#undef PG8_STAGE
#undef PG8_LDA
#undef PG8_LDB
#undef PG8_MMA
#undef PG8_WAIT_V
#undef PG8_WAIT_L
#undef PG8_BAR
#undef PG8_SCHED
}
}
namespace att {
typedef unsigned short bf16_t;
using bf16x8 = __attribute__((ext_vector_type(8))) short;
using s16x4  = __attribute__((ext_vector_type(4))) short;
using f32x16 = __attribute__((ext_vector_type(16))) float;
using u32x4  = __attribute__((ext_vector_type(4))) unsigned;
using f32x4  = __attribute__((ext_vector_type(4))) float;
constexpr int   D = 128, NW = 8, QBLK = 32, KVBLK = 64;
constexpr float SCALE = 0.088388347648318440f;
constexpr float THR = 8.f;
constexpr int LDP = 6144;
constexpr int LDO = 2048;
constexpr int SHM_V = KVBLK * D * 2, SHM_K = KVBLK * D * 2;
constexpr int SHM_WS_OFF = 2 * SHM_V + 2 * SHM_K, SHM_RPB_OFF = SHM_WS_OFF + NW * 64 * 4, SHM_ATTN = SHM_RPB_OFF + 2048;
constexpr int RPB_N = 15 * 31;

struct Unit {
  const bf16_t* Q; const bf16_t* K; const bf16_t* V;
  float* Of; bf16_t* Ob;
  const float* natab;
  int nt, nsplit, base1;
  int na, qrow0, kr0;
};

#define KSWZ(row, colB) ((row) * 256 + ((colB) ^ (((row) & 7) << 4)))
#define SBAR() __builtin_amdgcn_sched_barrier(0)
__device__ __forceinline__ int crow(int r, int hi) { return (r & 3) + 8 * (r >> 2) + 4 * hi; }
__device__ __forceinline__ unsigned cvtpk(float lo, float hi) { unsigned r; asm volatile("v_cvt_pk_bf16_f32 %0, %1, %2" : "=v"(r) : "v"(lo), "v"(hi)); return r; }
__device__ __forceinline__ bf16x8 ld8(const bf16_t* p) { return *reinterpret_cast<const bf16x8*>(p); }

__device__ __forceinline__ void partialSM(f32x16& p0, f32x16& p1, float& m_reg, float& mn, float& alpha) {
  constexpr float C = SCALE * 1.4426950408889634f;
  float pmax = p0[0];
#pragma unroll
  for (int r = 1; r < 16; ++r) pmax = fmaxf(pmax, p0[r]);
#pragma unroll
  for (int r = 0; r < 16; ++r) pmax = fmaxf(pmax, p1[r]);
  { auto rr = __builtin_amdgcn_permlane32_swap(__float_as_uint(pmax), __float_as_uint(pmax), false, false);
    pmax = fmaxf(__uint_as_float(rr[0]), __uint_as_float(rr[1])); }
  if (__builtin_expect(__all(pmax - m_reg <= THR / SCALE), 1)) { mn = m_reg; alpha = 1.f; }
  else { mn = fmaxf(m_reg, pmax); alpha = __builtin_amdgcn_exp2f((m_reg - mn) * C); m_reg = mn; }
  float mnC = -mn * C;
#pragma unroll
  for (int r = 0; r < 16; ++r) p0[r] = fmaf(p0[r], C, mnC);
#pragma unroll
  for (int r = 0; r < 16; ++r) p1[r] = fmaf(p1[r], C, mnC);
#pragma unroll
  for (int r = 0; r < 16; ++r) p0[r] = __builtin_amdgcn_exp2f(p0[r]);
}
__device__ __forceinline__ void finishSM(f32x16& p0, f32x16& p1, float alpha, float& l_reg, bf16x8& pa0, bf16x8& pa1, bf16x8& pa2, bf16x8& pa3) {
#pragma unroll
  for (int r = 0; r < 16; ++r) p1[r] = __builtin_amdgcn_exp2f(p1[r]);
  float ps = 0;
#pragma unroll
  for (int r = 0; r < 16; ++r) ps += p0[r];
#pragma unroll
  for (int r = 0; r < 16; ++r) ps += p1[r];
  { auto rr = __builtin_amdgcn_permlane32_swap(__float_as_uint(ps), __float_as_uint(ps), false, false);
    ps = __uint_as_float(rr[0]) + __uint_as_float(rr[1]); }
  l_reg = l_reg * alpha + ps;
#define PK4(P, BASE, OUT) do { unsigned a0 = cvtpk(P[BASE + 0], P[BASE + 1]), a1 = cvtpk(P[BASE + 2], P[BASE + 3]);   \
    unsigned b0 = cvtpk(P[BASE + 4], P[BASE + 5]), b1 = cvtpk(P[BASE + 6], P[BASE + 7]);                              \
    auto r0 = __builtin_amdgcn_permlane32_swap(a0, b0, false, false); auto r1 = __builtin_amdgcn_permlane32_swap(a1, b1, false, false); \
    u32x4 w = {r0[0], r1[0], r0[1], r1[1]}; OUT = *reinterpret_cast<bf16x8*>(&w); } while (0)
  PK4(p0, 0, pa0); PK4(p0, 8, pa1); PK4(p1, 0, pa2); PK4(p1, 8, pa3);
#undef PK4
}
__device__ __forceinline__ void qkt(f32x16& p0, f32x16& p1, const bf16_t* Ks, const bf16x8* qr, int r32, int hi) {
#pragma unroll
  for (int d0 = 0; d0 < 8; ++d0) { int cb = (d0 * 16 + hi * 8) * 2;
    bf16x8 b0 = *reinterpret_cast<const bf16x8*>((const char*)Ks + KSWZ(r32, cb));
    bf16x8 b1 = *reinterpret_cast<const bf16x8*>((const char*)Ks + KSWZ(32 + r32, cb));
    p0 = __builtin_amdgcn_mfma_f32_32x32x16_bf16(b0, qr[d0], p0, 0, 0, 0);
    p1 = __builtin_amdgcn_mfma_f32_32x32x16_bf16(b1, qr[d0], p1, 0, 0, 0); }
}
__device__ __forceinline__ int v_st(int k, int c) { const int kk = (k & ~0xC) | ((k & 4) << 1) | ((k & 8) >> 1); return ((kk >> 3) * 4 + (c >> 5)) * 512 + ((kk & 7) * 32 + (c & 31)) * 2; }
__device__ __forceinline__ int v_rd_base(int lane) { return ((lane & 3) << 3) | (((lane >> 2) & 3) << 6) | (((lane >> 4) & 1) << 5) | (((lane >> 5) & 1) << 8); }
constexpr int v_rd_off(int d0, int ks, int half) { return d0 * 512 + ks * 4096 + half * 2048; }
template <int OFF> __device__ __forceinline__ s16x4 tr_read(int vb) {
  s16x4 r; asm volatile("ds_read_b64_tr_b16 %0, %1 offset:%2" : "=&v"(r) : "v"(vb), "i"(OFF) : "memory"); return r;
}
template <int D0> __device__ __forceinline__ void pv_one(f32x16& od, int vb, bf16x8 pa0, bf16x8 pa1, bf16x8 pa2, bf16x8 pa3) {
  const s16x4 l0 = tr_read<v_rd_off(D0, 0, 0)>(vb), h0 = tr_read<v_rd_off(D0, 0, 1)>(vb), l1 = tr_read<v_rd_off(D0, 1, 0)>(vb), h1 = tr_read<v_rd_off(D0, 1, 1)>(vb);
  const s16x4 l2 = tr_read<v_rd_off(D0, 2, 0)>(vb), h2 = tr_read<v_rd_off(D0, 2, 1)>(vb), l3 = tr_read<v_rd_off(D0, 3, 0)>(vb), h3 = tr_read<v_rd_off(D0, 3, 1)>(vb);
  asm volatile("s_waitcnt lgkmcnt(0)" ::: "memory"); SBAR();
#define PK(L, H) (bf16x8){L[0], L[1], L[2], L[3], H[0], H[1], H[2], H[3]}
  od = __builtin_amdgcn_mfma_f32_32x32x16_bf16(pa0, PK(l0, h0), od, 0, 0, 0);
  od = __builtin_amdgcn_mfma_f32_32x32x16_bf16(pa1, PK(l1, h1), od, 0, 0, 0);
  od = __builtin_amdgcn_mfma_f32_32x32x16_bf16(pa2, PK(l2, h2), od, 0, 0, 0);
  od = __builtin_amdgcn_mfma_f32_32x32x16_bf16(pa3, PK(l3, h3), od, 0, 0, 0);
#undef PK
}
__device__ __forceinline__ void pv_d0(f32x16* o, int vb, bf16x8 pa0, bf16x8 pa1, bf16x8 pa2, bf16x8 pa3) {
  pv_one<0>(o[0], vb, pa0, pa1, pa2, pa3); pv_one<1>(o[1], vb, pa0, pa1, pa2, pa3); pv_one<2>(o[2], vb, pa0, pa1, pa2, pa3); pv_one<3>(o[3], vb, pa0, pa1, pa2, pa3);
}
template <bool NA> __device__ __forceinline__ void acc_init(f32x16& p0, f32x16& p1, int j, const Unit& U, int wid, int r32, int hi) {
  if constexpr (!NA) { p0 = f32x16{}; p1 = f32x16{}; }
  else {
    int slice = 16;
    if (j >= U.nsplit) { const int kr = U.kr0 + (j - U.nsplit), qr_ = U.qrow0 + (wid >> 1); int rs = qr_ - 4; rs = rs < 0 ? 0 : (rs > 248 ? 248 : rs);
      slice = (kr >= rs && kr < rs + 8) ? (kr - qr_ + 7) : 15; }
    const float* tb = U.natab + (size_t)slice * 4096 + (unsigned)(((wid & 1) * 32 + r32) * 64 + 4 * hi);
#pragma unroll
    for (int q = 0; q < 4; ++q) { const f32x4 a = *(const f32x4*)(tb + 8 * q), b = *(const f32x4*)(tb + 32 + 8 * q);
      p0[4 * q + 0] = a[0]; p0[4 * q + 1] = a[1]; p0[4 * q + 2] = a[2]; p0[4 * q + 3] = a[3];
      p1[4 * q + 0] = b[0]; p1[4 * q + 1] = b[1]; p1[4 * q + 2] = b[2]; p1[4 * q + 3] = b[3]; }
  }
}

template <bool NA> __device__ __forceinline__ void unit_body(const Unit& U, char* lds) {
  int tid = threadIdx.x; asm volatile("" : "+v"(tid)); const int wid = __builtin_amdgcn_readfirstlane(tid >> 6), lane = tid & 63, r32 = lane & 31, hi = lane >> 5;
  bf16_t* V_lds = (bf16_t*)lds; bf16_t* K_lds = (bf16_t*)(lds + 2 * SHM_V);
  float* ws = (float*)(lds + SHM_WS_OFF) + wid * 64; float* li_l = ws; float* al_l = ws + 32;
  float m_reg = -1e30f, l_reg = 0; f32x16 o[4] = {}; bf16x8 qr[8];
  const bf16_t* Qw = U.Q + (long)(wid * QBLK + r32) * LDP + hi * 8;
#pragma unroll
  for (int d0 = 0; d0 < 8; ++d0) qr[d0] = ld8(Qw + d0 * 16);
  const int sr = tid >> 4, sc = (tid & 15) * 8, vst0 = v_st(sr, sc), vst1 = v_st(32 + sr, sc);
  const int vb0 = (int)(uintptr_t)V_lds + v_rd_base(lane);
  struct { bf16x8 vs0, vs1, ks0, ks1; } sr_[2];
  const int nsplit = U.nsplit, base1 = U.base1;
#define TROW(j_) ((long)((j_) < nsplit ? (j_) * KVBLK : base1 + ((j_) - nsplit) * KVBLK))
#define SLOAD(i, j_) do { const long rb_ = TROW(j_); sr_[i].vs0 = ld8(&U.V[(rb_ + sr) * LDP + sc]); sr_[i].vs1 = ld8(&U.V[(rb_ + 32 + sr) * LDP + sc]); \
    sr_[i].ks0 = ld8(&U.K[(rb_ + sr) * LDP + sc]); sr_[i].ks1 = ld8(&U.K[(rb_ + 32 + sr) * LDP + sc]); } while (0)
#define SWRITE(b, i) do { *(bf16x8*)((char*)V_lds + (b) * SHM_V + vst0) = sr_[i].vs0;          \
    *(bf16x8*)((char*)V_lds + (b) * SHM_V + vst1) = sr_[i].vs1; int kc = sc * 2;               \
    *(bf16x8*)((char*)K_lds + (b) * SHM_K + KSWZ(sr, kc)) = sr_[i].ks0;                       \
    *(bf16x8*)((char*)K_lds + (b) * SHM_K + KSWZ(32 + sr, kc)) = sr_[i].ks1; } while (0)
#define SWAIT() asm volatile("s_waitcnt vmcnt(4)" ::: "memory")
#define RESC(a) do { if (__any((a) < 1.f)) { if (hi == 0) al_l[r32] = (a); asm volatile("s_waitcnt lgkmcnt(0)" ::: "memory"); \
    _Pragma("unroll") for (int d = 0; d < 4; ++d) _Pragma("unroll") for (int r = 0; r < 16; ++r) o[d][r] *= al_l[crow(r, hi)]; } } while (0)
  f32x16 pA0, pA1, pB0, pB1; float mnA, mnB, alA, alB; bf16x8 pa0, pa1, pa2, pa3; const int NT = U.nt;
  constexpr int SE = 0, SO = 1;
  SLOAD(SE, 0); asm volatile("s_waitcnt vmcnt(0)" ::: "memory"); SWRITE(0, SE); __syncthreads();
  acc_init<NA>(pA0, pA1, 0, U, wid, r32, hi); qkt(pA0, pA1, K_lds, qr, r32, hi); partialSM(pA0, pA1, m_reg, mnA, alA);
  SLOAD(SO, 1); if (2 < NT) SLOAD(SE, 2);
  SWAIT(); SWRITE(1, SO); __syncthreads();
  for (int j = 1; j + 1 < NT; j += 2) {
    SBAR(); acc_init<NA>(pB0, pB1, j, U, wid, r32, hi); qkt(pB0, pB1, (bf16_t*)((char*)K_lds + SHM_K), qr, r32, hi);
    finishSM(pA0, pA1, alA, l_reg, pa0, pa1, pa2, pa3); SBAR();
    SLOAD(SO, j + 2); SBAR();
    pv_d0(o, vb0, pa0, pa1, pa2, pa3); partialSM(pB0, pB1, m_reg, mnB, alB);
    __syncthreads(); SWAIT(); SWRITE(0, SE);
    RESC(alB); __syncthreads();
    SBAR(); acc_init<NA>(pA0, pA1, j + 1, U, wid, r32, hi); qkt(pA0, pA1, K_lds, qr, r32, hi);
    finishSM(pB0, pB1, alB, l_reg, pa0, pa1, pa2, pa3); SBAR();
    if (j + 3 < NT) SLOAD(SE, j + 3); SBAR();
    pv_d0(o, vb0 + (int)SHM_V, pa0, pa1, pa2, pa3); partialSM(pA0, pA1, m_reg, mnA, alA);
    __syncthreads(); SWAIT(); SWRITE(1, SO);
    RESC(alA); __syncthreads();
  }
  SBAR(); acc_init<NA>(pB0, pB1, NT - 1, U, wid, r32, hi); qkt(pB0, pB1, (bf16_t*)((char*)K_lds + SHM_K), qr, r32, hi);
  finishSM(pA0, pA1, alA, l_reg, pa0, pa1, pa2, pa3); SBAR();
  pv_d0(o, vb0, pa0, pa1, pa2, pa3); partialSM(pB0, pB1, m_reg, mnB, alB);
  __syncthreads(); RESC(alB);
  finishSM(pB0, pB1, alB, l_reg, pa0, pa1, pa2, pa3); SBAR();
  pv_d0(o, vb0 + (int)SHM_V, pa0, pa1, pa2, pa3);
  if (hi == 0) li_l[r32] = l_reg; asm volatile("s_waitcnt lgkmcnt(0)" ::: "memory");
  float rli[16];
#pragma unroll
  for (int r = 0; r < 16; ++r) rli[r] = __builtin_amdgcn_rcpf(li_l[crow(r, hi)]);
  if (U.Of) {
    float* Ow = U.Of + (long)(wid * QBLK) * LDO;
#pragma unroll
    for (int r = 0; r < 16; ++r) { const int orow = crow(r, hi);
#pragma unroll
      for (int d0 = 0; d0 < 4; ++d0) Ow[(long)orow * LDO + d0 * 32 + r32] = o[d0][r] * rli[r]; }
  } else {
    bf16_t* Ow = U.Ob + (long)(wid * QBLK) * LDO;
#pragma unroll
    for (int r = 0; r < 16; ++r) { const int orow = crow(r, hi);
#pragma unroll
      for (int d0 = 0; d0 < 4; ++d0) Ow[(long)orow * LDO + d0 * 32 + r32] = (bf16_t)(cvtpk(o[d0][r] * rli[r], 0.f) & 0xffffu); }
  }
  __syncthreads();
#undef TROW
#undef SLOAD
#undef SWRITE
#undef SWAIT
#undef RESC
}

constexpr int DA_VB = 32768, DA_KB = 16384, DA_WS_OFF = 2 * DA_VB + 2 * DA_KB, SHM_DA = DA_WS_OFF + NW * 64 * 4;
template <int D0, int KS0> __device__ __forceinline__ void pv_half(f32x16& od, int vb, bf16x8 paA, bf16x8 paB) {
  constexpr int IMG = (D0 >> 2) * 16384, DD = D0 & 3;
  const s16x4 l0 = tr_read<IMG + v_rd_off(DD, KS0, 0)>(vb), h0 = tr_read<IMG + v_rd_off(DD, KS0, 1)>(vb), l1 = tr_read<IMG + v_rd_off(DD, KS0 + 1, 0)>(vb), h1 = tr_read<IMG + v_rd_off(DD, KS0 + 1, 1)>(vb);
  asm volatile("s_waitcnt lgkmcnt(0)" ::: "memory"); SBAR();
#define PK(L, H) (bf16x8){L[0], L[1], L[2], L[3], H[0], H[1], H[2], H[3]}
  od = __builtin_amdgcn_mfma_f32_32x32x16_bf16(paA, PK(l0, h0), od, 0, 0, 0);
  od = __builtin_amdgcn_mfma_f32_32x32x16_bf16(paB, PK(l1, h1), od, 0, 0, 0);
#undef PK
}
template <int D0> __device__ __forceinline__ void pv_one2(f32x16& od, int vb, bf16x8 pa0, bf16x8 pa1, bf16x8 pa2, bf16x8 pa3) {
  constexpr int IMG = (D0 >> 2) * 16384, DD = D0 & 3;
  const s16x4 l0 = tr_read<IMG + v_rd_off(DD, 0, 0)>(vb), h0 = tr_read<IMG + v_rd_off(DD, 0, 1)>(vb), l1 = tr_read<IMG + v_rd_off(DD, 1, 0)>(vb), h1 = tr_read<IMG + v_rd_off(DD, 1, 1)>(vb);
  const s16x4 l2 = tr_read<IMG + v_rd_off(DD, 2, 0)>(vb), h2 = tr_read<IMG + v_rd_off(DD, 2, 1)>(vb), l3 = tr_read<IMG + v_rd_off(DD, 3, 0)>(vb), h3 = tr_read<IMG + v_rd_off(DD, 3, 1)>(vb);
  asm volatile("s_waitcnt lgkmcnt(0)" ::: "memory"); SBAR();
#define PK(L, H) (bf16x8){L[0], L[1], L[2], L[3], H[0], H[1], H[2], H[3]}
  od = __builtin_amdgcn_mfma_f32_32x32x16_bf16(pa0, PK(l0, h0), od, 0, 0, 0);
  od = __builtin_amdgcn_mfma_f32_32x32x16_bf16(pa1, PK(l1, h1), od, 0, 0, 0);
  od = __builtin_amdgcn_mfma_f32_32x32x16_bf16(pa2, PK(l2, h2), od, 0, 0, 0);
  od = __builtin_amdgcn_mfma_f32_32x32x16_bf16(pa3, PK(l3, h3), od, 0, 0, 0);
#undef PK
}
template <int I> __device__ __forceinline__ void pv_rd(int vb, s16x4& l, s16x4& h) {
  constexpr int D0 = I >> 2, KS = I & 3, IMG = (D0 >> 2) * 16384, DD = D0 & 3;
  l = tr_read<IMG + v_rd_off(DD, KS, 0)>(vb); h = tr_read<IMG + v_rd_off(DD, KS, 1)>(vb);
}
template <int I> __device__ __forceinline__ void pv_step(f32x16* o, int vb, const bf16x8 (&pa)[4], s16x4 (&l)[3], s16x4 (&h)[3]) {
  if constexpr (I + 2 < 32) pv_rd<(I + 2 < 32 ? I + 2 : 0)>(vb, l[(I + 2) % 3], h[(I + 2) % 3]);
  if constexpr (I + 2 < 32) asm volatile("s_waitcnt lgkmcnt(4)" ::: "memory"); else if constexpr (I + 1 < 32) asm volatile("s_waitcnt lgkmcnt(2)" ::: "memory"); else asm volatile("s_waitcnt lgkmcnt(0)" ::: "memory");
  SBAR();
  const s16x4 L = l[I % 3], H = h[I % 3];
  o[I >> 2] = __builtin_amdgcn_mfma_f32_32x32x16_bf16(pa[I & 3], (bf16x8){L[0], L[1], L[2], L[3], H[0], H[1], H[2], H[3]}, o[I >> 2], 0, 0, 0);
  SBAR();
  if constexpr (I + 1 < 32) pv_step<(I + 1 < 32 ? I + 1 : 31)>(o, vb, pa, l, h);
}
__device__ __forceinline__ void pv_all_rolling(f32x16* o, int vb, bf16x8 pa0, bf16x8 pa1, bf16x8 pa2, bf16x8 pa3) {
  const bf16x8 pa[4] = {pa0, pa1, pa2, pa3}; s16x4 l[3], h[3];
  asm volatile("s_waitcnt lgkmcnt(0)" ::: "memory");
  pv_rd<0>(vb, l[0], h[0]); pv_rd<1>(vb, l[1], h[1]);
  pv_step<0>(o, vb, pa, l, h);
}
template <int OFF> __device__ __forceinline__ bf16x8 k_read(int a) { bf16x8 r; asm volatile("ds_read_b128 %0, %1 offset:%2" : "=&v"(r) : "v"(a), "i"(OFF) : "memory"); return r; }
template <int BUFOFF, int D0> __device__ __forceinline__ void qk_step(f32x16& p0, f32x16& p1, int ka0, const bf16x8 (&qr)[8], bf16x8 (&k0)[2], bf16x8 (&k1)[2]) {
  if constexpr (D0 + 1 < 8) { const int a_ = ka0 ^ ((D0 + 1) << 5); k0[(D0 + 1) & 1] = k_read<BUFOFF>(a_); k1[(D0 + 1) & 1] = k_read<BUFOFF + 8192>(a_); }
  if constexpr (D0 + 1 < 8) asm volatile("s_waitcnt lgkmcnt(2)" ::: "memory"); else asm volatile("s_waitcnt lgkmcnt(0)" ::: "memory");
  SBAR();
  p0 = __builtin_amdgcn_mfma_f32_32x32x16_bf16(k0[D0 & 1], qr[D0], p0, 0, 0, 0);
  p1 = __builtin_amdgcn_mfma_f32_32x32x16_bf16(k1[D0 & 1], qr[D0], p1, 0, 0, 0);
  SBAR();
  if constexpr (D0 + 1 < 8) qk_step<BUFOFF, (D0 + 1 < 8 ? D0 + 1 : 7)>(p0, p1, ka0, qr, k0, k1);
}
template <int BUFOFF> __device__ __forceinline__ void qkt_rolling(f32x16& p0, f32x16& p1, int ka0, const bf16x8 (&qr)[8]) {
  bf16x8 k0[2], k1[2];
  asm volatile("s_waitcnt lgkmcnt(0)" ::: "memory");
  k0[0] = k_read<BUFOFF>(ka0); k1[0] = k_read<BUFOFF + 8192>(ka0);
  qk_step<BUFOFF, 0>(p0, p1, ka0, qr, k0, k1);
}
__device__ __forceinline__ void qkt_half(f32x16& p, const char* Ks, const bf16x8* qr, int row, int hi) {
#pragma unroll
  for (int d0 = 0; d0 < 8; ++d0) { const int cb = (d0 * 16 + hi * 8) * 2;
    const bf16x8 b = *reinterpret_cast<const bf16x8*>(Ks + KSWZ(row, cb));
    p = __builtin_amdgcn_mfma_f32_32x32x16_bf16(b, qr[d0], p, 0, 0, 0); }
}
__device__ __forceinline__ void unit_body_da(const Unit& U, char* lds) {
  int tid = threadIdx.x; asm volatile("" : "+v"(tid)); const int wid = __builtin_amdgcn_readfirstlane(tid >> 6), lane = tid & 63, r32 = lane & 31, hi = lane >> 5;
  char* V_lds = lds; char* K_lds = lds + 2 * DA_VB;
  float* ws = (float*)(lds + DA_WS_OFF) + wid * 64; float* li_l = ws; float* al_l = ws + 32;
  float m_reg = -1e30f, l_reg = 0; f32x16 o[8] = {}; bf16x8 qr[8];
  const bf16_t* Qw = U.Q + (long)(wid * QBLK + r32) * LDP + hi * 8;
#pragma unroll
  for (int d0 = 0; d0 < 8; ++d0) qr[d0] = ld8(Qw + d0 * 16);
  const int vb0 = (int)(uintptr_t)V_lds + v_rd_base(lane);
  const int ka0 = (int)(uintptr_t)K_lds + KSWZ(r32, hi * 16);
  constexpr float C = SCALE * 1.4426950408889634f;
  unsigned koff[2], voff[2][2];
#pragma unroll
  for (int i = 0; i < 2; ++i) { const int ob = (2 * wid + i) * 1024 + lane * 16;
    { const int row = ob >> 8, cpos = (ob >> 4) & 15, c = cpos ^ (row & 7); koff[i] = (unsigned)(row * LDP + c * 8); }
    { const int st = ob >> 9, kk = (st >> 2) * 8 + ((ob >> 6) & 7), c = (st & 3) * 32 + ((ob >> 1) & 31), k = (kk & ~0xC) | ((kk & 4) << 1) | ((kk & 8) >> 1);
      voff[0][i] = (unsigned)(k * LDP + c); voff[1][i] = (unsigned)(k * LDP + 128 + c); } }
  typedef __attribute__((address_space(3))) unsigned lds_u32;
#define DDMA(j_, b) do { const bf16_t* kb_ = U.K + (long)(j_) * KVBLK * LDP; const bf16_t* vb__ = U.V + (long)(j_) * KVBLK * LDP; \
    _Pragma("unroll") for (int i = 0; i < 2; ++i) { \
      __builtin_amdgcn_global_load_lds((const unsigned*)(kb_ + koff[i]), (lds_u32*)(K_lds + (b) * DA_KB + (2 * wid + i) * 1024), 16, 0, 0); \
      __builtin_amdgcn_global_load_lds((const unsigned*)(vb__ + voff[0][i]), (lds_u32*)(V_lds + (b) * DA_VB + (2 * wid + i) * 1024), 16, 0, 0); \
      __builtin_amdgcn_global_load_lds((const unsigned*)(vb__ + voff[1][i]), (lds_u32*)(V_lds + (b) * DA_VB + 16384 + (2 * wid + i) * 1024), 16, 0, 0); } } while (0)
#define DPUB() do { asm volatile("s_waitcnt vmcnt(0)" ::: "memory"); __syncthreads(); } while (0)
#define DHALF(b, ROW0, paA, paB) do { f32x16 p = f32x16{}; qkt_half(p, K_lds + (b) * DA_KB, qr, (ROW0) + r32, hi); \
    float pmax = p[0]; _Pragma("unroll") for (int r = 1; r < 16; ++r) pmax = fmaxf(pmax, p[r]); \
    { auto rr = __builtin_amdgcn_permlane32_swap(__float_as_uint(pmax), __float_as_uint(pmax), false, false); pmax = fmaxf(__uint_as_float(rr[0]), __uint_as_float(rr[1])); } \
    float mn, al; if (__builtin_expect(__all(pmax - m_reg <= THR / SCALE), 1)) { mn = m_reg; al = 1.f; } else { mn = fmaxf(m_reg, pmax); al = __builtin_amdgcn_exp2f((m_reg - mn) * C); m_reg = mn; } \
    if (__any(al < 1.f)) { if (hi == 0) al_l[r32] = al; asm volatile("s_waitcnt lgkmcnt(0)" ::: "memory"); \
      _Pragma("unroll") for (int r = 0; r < 16; ++r) { const float f_ = al_l[crow(r, hi)]; _Pragma("unroll") for (int d = 0; d < 8; ++d) o[d][r] *= f_; } } \
    const float mnC = -mn * C; float ps = 0.f; \
    _Pragma("unroll") for (int r = 0; r < 16; ++r) { p[r] = __builtin_amdgcn_exp2f(fmaf(p[r], C, mnC)); ps += p[r]; } \
    { auto rr = __builtin_amdgcn_permlane32_swap(__float_as_uint(ps), __float_as_uint(ps), false, false); ps = __uint_as_float(rr[0]) + __uint_as_float(rr[1]); } \
    l_reg = l_reg * al + ps; \
    { unsigned a0 = cvtpk(p[0], p[1]), a1 = cvtpk(p[2], p[3]), b0 = cvtpk(p[4], p[5]), b1 = cvtpk(p[6], p[7]); \
      auto r0 = __builtin_amdgcn_permlane32_swap(a0, b0, false, false); auto r1 = __builtin_amdgcn_permlane32_swap(a1, b1, false, false); u32x4 w = {r0[0], r1[0], r0[1], r1[1]}; paA = *reinterpret_cast<bf16x8*>(&w); } \
    { unsigned a0 = cvtpk(p[8], p[9]), a1 = cvtpk(p[10], p[11]), b0 = cvtpk(p[12], p[13]), b1 = cvtpk(p[14], p[15]); \
      auto r0 = __builtin_amdgcn_permlane32_swap(a0, b0, false, false); auto r1 = __builtin_amdgcn_permlane32_swap(a1, b1, false, false); u32x4 w = {r0[0], r1[0], r0[1], r1[1]}; paB = *reinterpret_cast<bf16x8*>(&w); } } while (0)
#define DPV(b, KS0, paA, paB) do { const int vb_ = vb0 + (b) * DA_VB; \
    pv_half<0, KS0>(o[0], vb_, paA, paB); pv_half<1, KS0>(o[1], vb_, paA, paB); pv_half<2, KS0>(o[2], vb_, paA, paB); pv_half<3, KS0>(o[3], vb_, paA, paB); \
    pv_half<4, KS0>(o[4], vb_, paA, paB); pv_half<5, KS0>(o[5], vb_, paA, paB); pv_half<6, KS0>(o[6], vb_, paA, paB); pv_half<7, KS0>(o[7], vb_, paA, paB); } while (0)
#define DRESC(a) do { if (__any((a) < 1.f)) { if (hi == 0) al_l[r32] = (a); asm volatile("s_waitcnt lgkmcnt(0)" ::: "memory"); \
    _Pragma("unroll") for (int r = 0; r < 16; ++r) { const float f_ = al_l[crow(r, hi)]; _Pragma("unroll") for (int d = 0; d < 8; ++d) o[d][r] *= f_; } } } while (0)
#define DTILE(b) do { f32x16 p0 = f32x16{}, p1 = f32x16{}; float mn, al; bf16x8 pa0, pa1, pa2, pa3; \
    qkt_rolling<(b) * DA_KB>(p0, p1, ka0, qr); partialSM(p0, p1, m_reg, mn, al); DRESC(al); finishSM(p0, p1, al, l_reg, pa0, pa1, pa2, pa3); SBAR(); \
    pv_all_rolling(o, vb0 + (b) * DA_VB, pa0, pa1, pa2, pa3); } while (0)
  const int NT = U.nt;
  DDMA(0, 0); DPUB();
  for (int j = 0; j < NT; j += 2) {
    DDMA(j + 1, 1); SBAR();
    DTILE(0); SBAR(); DPUB();
    if (j + 2 < NT) DDMA(j + 2, 0); SBAR();
    DTILE(1); SBAR(); DPUB();
  }
  if (hi == 0) li_l[r32] = l_reg; asm volatile("s_waitcnt lgkmcnt(0)" ::: "memory");
  float* Ow = U.Of + (long)(wid * QBLK) * LDO;
#pragma unroll
  for (int r = 0; r < 16; ++r) { const int orow = crow(r, hi); const float rl = __builtin_amdgcn_rcpf(li_l[orow]);
#pragma unroll
    for (int d0 = 0; d0 < 8; ++d0) Ow[(long)orow * LDO + d0 * 32 + r32] = o[d0][r] * rl; }
  __syncthreads();
#undef DDMA
#undef DPUB
#undef DHALF
#undef DPV
#undef DTILE
#undef DRESC
}

template <int I> __device__ __forceinline__ void pv4_step(f32x16* o, int vb, const bf16x8 (&pa)[4], s16x4 (&l)[3], s16x4 (&h)[3]) {
  if constexpr (I + 2 < 16) pv_rd<(I + 2 < 16 ? I + 2 : 0)>(vb, l[(I + 2) % 3], h[(I + 2) % 3]);
  if constexpr (I + 2 < 16) asm volatile("s_waitcnt lgkmcnt(4)" ::: "memory"); else if constexpr (I + 1 < 16) asm volatile("s_waitcnt lgkmcnt(2)" ::: "memory"); else asm volatile("s_waitcnt lgkmcnt(0)" ::: "memory");
  SBAR();
  const s16x4 L = l[I % 3], H = h[I % 3];
  o[I >> 2] = __builtin_amdgcn_mfma_f32_32x32x16_bf16(pa[I & 3], (bf16x8){L[0], L[1], L[2], L[3], H[0], H[1], H[2], H[3]}, o[I >> 2], 0, 0, 0);
  SBAR();
  if constexpr (I + 1 < 16) pv4_step<(I + 1 < 16 ? I + 1 : 15)>(o, vb, pa, l, h);
}
template <bool NA> __device__ __forceinline__ void unit_body_v128(const Unit& U, char* lds) {
  int tid = threadIdx.x; asm volatile("" : "+v"(tid)); const int wid = __builtin_amdgcn_readfirstlane(tid >> 6), lane = tid & 63, r32 = lane & 31, hi = lane >> 5;
  char* V_lds = lds; char* K_lds = lds + 2 * DA_VB;
  float* ws = (float*)(lds + DA_WS_OFF) + wid * 64; float* li_l = ws; float* al_l = ws + 32;
  float m_reg = -1e30f, l_reg = 0; f32x16 o[4] = {}; bf16x8 qr[8];
  const bf16_t* Qw = U.Q + (long)(wid * QBLK + r32) * LDP + hi * 8;
#pragma unroll
  for (int d0 = 0; d0 < 8; ++d0) qr[d0] = ld8(Qw + d0 * 16);
  const int vb0 = (int)(uintptr_t)V_lds + v_rd_base(lane);
  const int ka0 = (int)(uintptr_t)K_lds + KSWZ(r32, hi * 16);
  unsigned koff[2], voff[2];
#pragma unroll
  for (int i = 0; i < 2; ++i) { const int ob = (2 * wid + i) * 1024 + lane * 16;
    { const int row = ob >> 8, cpos = (ob >> 4) & 15, c = cpos ^ (row & 7); koff[i] = (unsigned)(row * LDP + c * 8); }
    { const int st = ob >> 9, kk = (st >> 2) * 8 + ((ob >> 6) & 7), c = (st & 3) * 32 + ((ob >> 1) & 31), k = (kk & ~0xC) | ((kk & 4) << 1) | ((kk & 8) >> 1); voff[i] = (unsigned)(k * LDP + c); } }
  typedef __attribute__((address_space(3))) unsigned lds_u32;
  const int nsplit = U.nsplit, base1 = U.base1;
#define NROW(j_) ((long)((j_) < nsplit ? (j_) * KVBLK : base1 + ((j_) - nsplit) * KVBLK))
#define NDMA(j_, b) do { const long rb_ = NROW(j_); const bf16_t* kb_ = U.K + rb_ * LDP; const bf16_t* vb__ = U.V + rb_ * LDP; \
    _Pragma("unroll") for (int i = 0; i < 2; ++i) { \
      __builtin_amdgcn_global_load_lds((const unsigned*)(kb_ + koff[i]), (lds_u32*)(K_lds + (b) * DA_KB + (2 * wid + i) * 1024), 16, 0, 0); \
      __builtin_amdgcn_global_load_lds((const unsigned*)(vb__ + voff[i]), (lds_u32*)(V_lds + (b) * DA_VB + (2 * wid + i) * 1024), 16, 0, 0); } } while (0)
#define NPUB() do { asm volatile("s_waitcnt vmcnt(0)" ::: "memory"); __syncthreads(); } while (0)
#define NRESC(a) do { if (__any((a) < 1.f)) { if (hi == 0) al_l[r32] = (a); asm volatile("s_waitcnt lgkmcnt(0)" ::: "memory"); \
    _Pragma("unroll") for (int r = 0; r < 16; ++r) { const float f_ = al_l[crow(r, hi)]; _Pragma("unroll") for (int d = 0; d < 4; ++d) o[d][r] *= f_; } } } while (0)
#define NTILE(b) do { float mn, al; bf16x8 pa0, pa1, pa2, pa3; \
    qkt_rolling<(b) * DA_KB>(p0, p1, ka0, qr); partialSM(p0, p1, m_reg, mn, al); NRESC(al); finishSM(p0, p1, al, l_reg, pa0, pa1, pa2, pa3); SBAR(); \
    { const bf16x8 pa[4] = {pa0, pa1, pa2, pa3}; s16x4 l[3], h[3]; const int vb_ = vb0 + (b) * DA_VB; asm volatile("s_waitcnt lgkmcnt(0)" ::: "memory"); \
      pv_rd<0>(vb_, l[0], h[0]); pv_rd<1>(vb_, l[1], h[1]); pv4_step<0>(o, vb_, pa, l, h); } } while (0)
  const int NT = U.nt;
  NDMA(0, 0); NPUB();
  for (int j = 0; j < NT; j += 2) {
    f32x16 p0, p1;
    acc_init<NA>(p0, p1, j, U, wid, r32, hi); SBAR();
    NDMA(j + 1, 1); SBAR();
    NTILE(0); SBAR(); NPUB();
    acc_init<NA>(p0, p1, j + 1, U, wid, r32, hi); SBAR();
    if (j + 2 < NT) NDMA(j + 2, 0); SBAR();
    NTILE(1); SBAR(); NPUB();
  }
  if (hi == 0) li_l[r32] = l_reg; asm volatile("s_waitcnt lgkmcnt(0)" ::: "memory");
  if (U.Of) {
    float* Ow = U.Of + (long)(wid * QBLK) * LDO;
#pragma unroll
    for (int r = 0; r < 16; ++r) { const int orow = crow(r, hi); const float rl = __builtin_amdgcn_rcpf(li_l[orow]);
#pragma unroll
      for (int d0 = 0; d0 < 4; ++d0) Ow[(long)orow * LDO + d0 * 32 + r32] = o[d0][r] * rl; }
  } else {
    bf16_t* Ow = U.Ob + (long)(wid * QBLK) * LDO;
#pragma unroll
    for (int r = 0; r < 16; ++r) { const int orow = crow(r, hi); const float rl = __builtin_amdgcn_rcpf(li_l[orow]);
#pragma unroll
      for (int d0 = 0; d0 < 4; ++d0) Ow[(long)orow * LDO + d0 * 32 + r32] = (bf16_t)(cvtpk(o[d0][r] * rl, 0.f) & 0xffffu); }
  }
  __syncthreads();
#undef NROW
#undef NDMA
#undef NPUB
#undef NRESC
#undef NTILE
}
}
#define GAS __attribute__((address_space(1)))
#define LAS __attribute__((address_space(3)))
typedef unsigned short bf16;
typedef unsigned v4u __attribute__((ext_vector_type(4)));
typedef unsigned v2u __attribute__((ext_vector_type(2)));
typedef float f32x4 __attribute__((ext_vector_type(4)));

constexpr int DM = 2048, SEQL = 16384, LC = 256, MT = SEQL + LC;
constexpr int IN_DIM = 6144, DFF = 5632, NUP = 2 * DFF, NMOD = 6 * DM;
constexpr int NLAYER = 2;
constexpr float LN_EPS = 1e-5f;
constexpr float ALPHA = 1.41421356237309515f;

constexpr size_t MiB = 1u << 20;
constexpr size_t WS_MOD = 0;
constexpr size_t WS_BAR = 512 * 1024;
constexpr size_t WS_TICKET = WS_BAR + 16384;
constexpr size_t WS_LAMV = WS_BAR + 32768;
constexpr size_t WS_ROPE = 1 * MiB;
constexpr size_t WS_XC = 2 * MiB;
constexpr size_t WS_PART = 4 * MiB;
constexpr size_t WS_W = 18 * MiB;
constexpr size_t W_IN = 0, W_O = 24 * MiB, W_UP = 32 * MiB, W_DN = 76 * MiB, W_LAYER = 98 * MiB;
constexpr size_t WS_R1 = WS_W + 2 * W_LAYER;
constexpr size_t R1_T = 195 * MiB;
constexpr size_t WS_R2 = WS_R1 + 358 * MiB;
constexpr size_t R2_B = 65 * MiB;
constexpr size_t WS_SLAB_O = WS_R1 + 325 * MiB, WS_SLAB_D = WS_R1 + 65 * MiB;
constexpr int KSPLIT_O = 8, KSPLIT_D = 11;
constexpr size_t WS_NATAB = WS_R2 + 179 * MiB;
constexpr int NATAB_N = 17 * 4096;
constexpr size_t WS_END = WS_NATAB + 5 * MiB;
static_assert((size_t)MT * IN_DIM * 2 <= R1_T && R1_T + (size_t)MT * DM * 4 <= 358 * MiB && (size_t)MT * NUP * 2 <= 358 * MiB && (size_t)MT * DFF * 2 <= 179 * MiB && (size_t)MT * DM * 2 <= R2_B, "ws map");

struct Params { const float* in[19]; float* out; unsigned char* ws; };
enum { I_X = 0, I_C, I_CTX, I_CCTX, I_WADA, I_BADA, I_WIN, I_LAM, I_SUBLN, I_RPB, I_WO, I_LN1G, I_LN1B, I_WUP, I_CONVW, I_CONVB, I_WDN, I_LN2G, I_LN2B };

__device__ __forceinline__ unsigned f2bf(float f) { unsigned u = __builtin_bit_cast(unsigned, f); return (u + 0x7fffu + ((u >> 16) & 1u)) >> 16; }
__device__ __forceinline__ unsigned pk2(float lo, float hi) { return f2bf(lo) | (f2bf(hi) << 16); }
__device__ __forceinline__ float bflo(unsigned w) { return __uint_as_float(w << 16); }
__device__ __forceinline__ float bfhi(unsigned w) { return __uint_as_float(w & 0xffff0000u); }
__device__ __forceinline__ float wave_sum(float v, int lane) {
#pragma unroll
    for (int o = 1; o < 64; o <<= 1) v += __builtin_bit_cast(float, __builtin_amdgcn_ds_bpermute((lane ^ o) << 2, __builtin_bit_cast(int, v)));
    return v;
}
__device__ __forceinline__ float* xrow(const Params& P, int r) { return r < LC ? (float*)(P.ws + WS_XC) + (size_t)r * DM : P.out + (size_t)(r - LC) * DM; }

__device__ __forceinline__ int rope_perm_col(int n) { const int w = n & 127, p = w >> 6, partner = (w >> 5) & 1, i = w & 31, sub = i >> 2, jj = i & 3;
    return (n & ~127) + (p * 2 + (sub >> 2)) * 32 + (sub & 3) * 8 + partner * 4 + jj; }
template <bool ROPEP> __device__ __forceinline__ void transpose_item(const float* W, int K, int N, bf16* WT, LAS float* scr, int item, int lane) {
    const int nblk = N / 32, kb = item / nblk, nb = item % nblk, k0 = 64 * kb, n0 = 32 * nb;
    {
        f32x4 v[8]; const int kr = lane >> 3, nc = (lane & 7) * 4;
#pragma unroll
        for (int i = 0; i < 8; ++i) v[i] = *(const f32x4*)(W + (size_t)(k0 + 8 * i + kr) * N + n0 + nc);
#pragma unroll
        for (int i = 0; i < 8; ++i) { LAS float* d = scr + (8 * i + kr) * 33 + nc; d[0] = v[i][0]; d[1] = v[i][1]; d[2] = v[i][2]; d[3] = v[i][3]; }
    }
    asm volatile("s_waitcnt lgkmcnt(0)" ::: "memory");
    const int c = lane & 7;
#pragma unroll
    for (int j = 0; j < 4; ++j) { const int n = (lane >> 3) + 8 * j; const LAS float* s = scr + (8 * c) * 33 + n;
        v4u o; o.x = pk2(s[0 * 33], s[1 * 33]); o.y = pk2(s[2 * 33], s[3 * 33]); o.z = pk2(s[4 * 33], s[5 * 33]); o.w = pk2(s[6 * 33], s[7 * 33]);
        const int nr = (ROPEP && (n0 + n) < 2048) ? rope_perm_col(n0 + n) : (n0 + n);
        *(GAS v4u*)(WT + (size_t)nr * K + k0 + 8 * c) = o; }
    asm volatile("s_waitcnt lgkmcnt(0)" ::: "memory");
}

__device__ __forceinline__ void ph_prologue(const Params& P, unsigned char* lds, int tid, int lane, int wave, int G) {
    float* sl = (float*)lds;
    for (int i = tid; i < 2 * DM; i += 512) { const float v = i < DM ? P.in[I_C][i] : P.in[I_CCTX][i - DM]; sl[i] = v / (1.0f + __expf(-v)); }
    __syncthreads();
    float* part = (float*)(P.ws + WS_PART);
    for (int u = blockIdx.x; u < 2 * 64 * 6; u += G) {
        const int l = u / 384, rem = u % 384, kc = rem / 6, jc = rem % 6, k0 = kc * 32, j = jc * 2048 + tid * 4;
        const float* w = P.in[I_WADA] + ((size_t)l * DM + k0) * NMOD + j;
        f32x4 a0 = {0.f, 0.f, 0.f, 0.f}, a1 = {0.f, 0.f, 0.f, 0.f};
#pragma unroll 8
        for (int kk = 0; kk < 32; ++kk) { const f32x4 wv = *(const f32x4*)(w + (size_t)kk * NMOD); a0 += wv * sl[k0 + kk]; a1 += wv * sl[DM + k0 + kk]; }
        *(f32x4*)(part + ((size_t)(l * 64 + kc) * 2 + 0) * NMOD + j) = a0;
        *(f32x4*)(part + ((size_t)(l * 64 + kc) * 2 + 1) * NMOD + j) = a1;
    }
    const int gtid = blockIdx.x * 512 + tid;
    if (gtid < 320 * 32) {
        const int pos = gtid >> 5, i = gtid & 31; const float p = (float)(pos < 256 ? pos : pos - 256);
        const float inv = exp2f(-(float)(2 * i) * (13.287712379549449f / 64.0f)); const float ang = p * inv;
        const double rev = (double)ang * 0.15915494309189535; const float fr_ = (float)(rev - floor(rev));
        float* rt = (float*)(P.ws + WS_ROPE) + (size_t)gtid * 2; rt[0] = __builtin_amdgcn_cosf(fr_); rt[1] = __builtin_amdgcn_sinf(fr_);
    }
    if (blockIdx.x == 0 && wave < NLAYER) {
        const int l = wave; const float* lv = P.in[I_LAM] + (size_t)l * 4 * 128;
        const float s01 = wave_sum(lv[lane] * lv[128 + lane] + lv[64 + lane] * lv[192 + lane], lane);
        const float s23 = wave_sum(lv[256 + lane] * lv[384 + lane] + lv[320 + lane] * lv[448 + lane], lane);
        const float lam_init = 0.8f - 0.6f * expf(-0.3f * (float)l);
        if (lane == 0) { float* o = (float*)(P.ws + WS_LAMV) + 2 * l; o[0] = expf(s01) - expf(s23) + lam_init; o[1] = 1.0f - lam_init; }
    }
    {
        float* nt = (float*)(P.ws + WS_NATAB);
        for (int o = gtid; o < NLAYER * 8 * NATAB_N; o += G * 512) {
            const int lh = o / NATAB_N, rem = o % NATAB_N, slice = rem >> 12, c = (rem >> 6) & 63, kc = rem & 63;
            int cs = c - 8; cs = cs < 0 ? 0 : (cs > 48 ? 48 : cs);
            float v = 0.f;
            if (slice == 15) v = -1e30f;
            else if (slice < 15) v = (kc >= cs && kc < cs + 16) ? P.in[I_RPB][(size_t)lh * att::RPB_N + slice * 31 + (kc - c + 15)] * (1.0f / att::SCALE) : -1e30f;
            nt[o] = v;
        }
    }
    __syncthreads();
    LAS float* scr = (LAS float*)((LAS unsigned char*)lds + wave * 16384);
    const int gw = blockIdx.x * 8 + wave, NGW = G * 8;
    constexpr int I_1 = (DM / 64) * (IN_DIM / 32), I_2 = (DM / 64) * (DM / 32), I_3 = (DM / 64) * (NUP / 32), I_4 = (DFF / 64) * (DM / 32), I_L = I_1 + I_2 + I_3 + I_4;
    for (int it = gw; it < NLAYER * I_L; it += NGW) {
        const int l = it / I_L; int r = it % I_L; unsigned char* wl = P.ws + WS_W + (size_t)l * W_LAYER;
        if (r < I_1) { transpose_item<true>(P.in[I_WIN] + (size_t)l * DM * IN_DIM, DM, IN_DIM, (bf16*)(wl + W_IN), scr, r, lane); continue; } r -= I_1;
        if (r < I_2) { transpose_item<false>(P.in[I_WO] + (size_t)l * DM * DM, DM, DM, (bf16*)(wl + W_O), scr, r, lane); continue; } r -= I_2;
        if (r < I_3) { transpose_item<false>(P.in[I_WUP] + (size_t)l * DM * NUP, DM, NUP, (bf16*)(wl + W_UP), scr, r, lane); continue; } r -= I_3;
        transpose_item<false>(P.in[I_WDN] + (size_t)l * DFF * DM, DFF, DM, (bf16*)(wl + W_DN), scr, r, lane);
    }
}
__device__ __forceinline__ void ph_modreduce(const Params& P, int gtid, int NTH) {
    const float* part = (const float*)(P.ws + WS_PART); float* mod = (float*)(P.ws + WS_MOD);
    for (int o = gtid; o < NLAYER * 2 * NMOD; o += NTH) {
        const int l = o / (2 * NMOD), which = (o / NMOD) & 1, j = o % NMOD;
        float s = P.in[I_BADA][l * NMOD + j];
        for (int kc = 0; kc < 64; ++kc) s += part[((size_t)(l * 64 + kc) * 2 + which) * NMOD + j];
        mod[o] = s;
    }
}
__device__ __forceinline__ const float* modp(const Params& P, int l, int which, int k) { return (const float*)(P.ws + WS_MOD) + (size_t)(l * 2 + which) * NMOD + (size_t)k * DM; }

__device__ __forceinline__ void ph_modulate0(const Params& P, int gw, int NGW, int lane) {
    bf16* H = (bf16*)(P.ws + WS_R2);
    for (int r0 = gw; r0 < MT; r0 += 2 * NGW) {
        f32x4 xv[2][8];
#pragma unroll
        for (int q = 0; q < 2; ++q) { const int r = r0 + q * NGW; if (r < MT) { const float* src = r < LC ? P.in[I_CTX] + (size_t)r * DM : P.in[I_X] + (size_t)(r - LC) * DM;
#pragma unroll
            for (int j = 0; j < 8; ++j) xv[q][j] = *(const f32x4*)(src + 4 * lane + 256 * j); } }
#pragma unroll
        for (int q = 0; q < 2; ++q) { const int r = r0 + q * NGW; if (r < MT) { const int which = r < LC; const float* sh = modp(P, 0, which, 0); const float* sc = modp(P, 0, which, 1);
#pragma unroll
            for (int j = 0; j < 8; ++j) { const int col = 4 * lane + 256 * j; const f32x4 s = *(const f32x4*)(sc + col), t = *(const f32x4*)(sh + col);
                const f32x4 o = xv[q][j] * (s + 1.0f) + t; v2u w; w.x = pk2(o[0], o[1]); w.y = pk2(o[2], o[3]); *(v2u*)(H + (size_t)r * DM + col) = w; } } }
    }
}
__device__ __forceinline__ void ph_rope(const Params& P, int gw, int NGW, int lane) {
    bf16* proj = (bf16*)(P.ws + WS_R1); const float* tab = (const float*)(P.ws + WS_ROPE);
    for (int r0 = LC + gw; r0 < MT; r0 += 2 * NGW) {
        v4u a[2][2], bq[2][2];
#pragma unroll
        for (int q = 0; q < 2; ++q) { const int r = r0 + q * NGW; if (r < MT) { bf16* row = proj + (size_t)r * IN_DIM;
#pragma unroll
            for (int k = 0; k < 2; ++k) { const int unit = lane + 64 * k, b = unit >> 3, p = (unit >> 2) & 1, i0 = (unit & 3) * 8; const bf16* p1 = row + b * 128 + p * 64 + i0;
                a[q][k] = *(const v4u*)p1; bq[q][k] = *(const v4u*)(p1 + 32); } } }
#pragma unroll
        for (int q = 0; q < 2; ++q) { const int r = r0 + q * NGW; if (r < MT) { const int t = r - LC, pr = t >> 6, pc = t & 63; bf16* row = proj + (size_t)r * IN_DIM;
#pragma unroll
            for (int k = 0; k < 2; ++k) {
                const int unit = lane + 64 * k, b = unit >> 3, p = (unit >> 2) & 1, i0 = (unit & 3) * 8; bf16* p1 = row + b * 128 + p * 64 + i0;
                const float* tb = tab + ((size_t)(p ? 256 + pc : pr) * 32 + i0) * 2; v4u oa, ob;
#pragma unroll
                for (int e = 0; e < 4; ++e) {
                    const f32x4 cs = *(const f32x4*)(tb + 4 * e);
                    const float x1l = bflo(a[q][k][e]), x1h = bfhi(a[q][k][e]), x2l = bflo(bq[q][k][e]), x2h = bfhi(bq[q][k][e]);
                    oa[e] = pk2(x1l * cs[0] - x2l * cs[1], x1h * cs[2] - x2h * cs[3]);
                    ob[e] = pk2(x2l * cs[0] + x1l * cs[1], x2h * cs[2] + x1h * cs[3]);
                }
                *(v4u*)p1 = oa; *(v4u*)(p1 + 32) = ob;
            } } }
    }
}
__device__ __forceinline__ void ph_combine(const Params& P, int l, int gw, int NGW, int lane) {
    const float* T = (const float*)(P.ws + WS_R1 + R1_T); bf16* AO = (bf16*)(P.ws + WS_R2 + R2_B);
    const float lam = ((const float*)(P.ws + WS_LAMV))[2 * l], osc = ((const float*)(P.ws + WS_LAMV))[2 * l + 1];
    const f32x4 g = *(const f32x4*)(P.in[I_SUBLN] + (size_t)l * 256 + 4 * lane);
    const int r_lo = (l == NLAYER - 1) ? LC : 0;
    for (int r = r_lo + gw; r < MT; r += NGW) {
        f32x4 o1[4], o2[4];
#pragma unroll
        for (int h = 0; h < 4; ++h) { o1[h] = *(const f32x4*)(T + (size_t)r * DM + h * 512 + 4 * lane); o2[h] = *(const f32x4*)(T + (size_t)r * DM + h * 512 + 256 + 4 * lane); }
#pragma unroll
        for (int h = 0; h < 4; ++h) {
            const f32x4 d = o1[h] - o2[h] * lam;
            const float ss = wave_sum(d[0] * d[0] + d[1] * d[1] + d[2] * d[2] + d[3] * d[3], lane);
            const float rinv = 1.0f / sqrtf(ss * (1.0f / 256.0f) + LN_EPS);
            const f32x4 o = d * rinv * g * osc;
            v2u w; w.x = pk2(o[0], o[1]); w.y = pk2(o[2], o[3]); *(v2u*)(AO + (size_t)r * DM + h * 256 + 4 * lane) = w;
        }
    }
}
__device__ __forceinline__ void ph_ln(const Params& P, int l, int stage, unsigned char* lds, int tid, int gw, int NGW, int lane) {
    const bool last = (l == NLAYER - 1);
    const bf16* ADD = stage == 1 ? (const bf16*)(P.ws + WS_R2) : (const bf16*)(P.ws + WS_R1);
    bf16* HN = stage == 1 ? (bf16*)(P.ws + WS_R2 + R2_B) : (bf16*)(P.ws + WS_R2);
    const float* lg = (stage == 1 ? P.in[I_LN1G] : P.in[I_LN2G]) + (size_t)l * DM; const float* lb = (stage == 1 ? P.in[I_LN1B] : P.in[I_LN2B]) + (size_t)l * DM;
    const float* SLAB = (const float*)(P.ws + (stage == 1 ? WS_SLAB_O : WS_SLAB_D));
    const bool write_h = (stage == 1) || !last;
    const int r_lo = last ? LC : 0, lsc = stage == 1 ? l : (last ? l : l + 1);
    float* V = (float*)lds;
    for (int i = tid; i < 8 * DM; i += 512) {
        const int k = i / DM, c = i % DM; float v;
        if (k == 3) v = lg[c]; else if (k == 4) v = lb[c];
        else { const int which = k >= 5, kk = which ? k - 5 : k;
            v = kk == 0 ? modp(P, l, which, stage == 1 ? 2 : 5)[c] : (kk == 1 ? modp(P, lsc, which, stage == 1 ? 4 : 1)[c] : modp(P, lsc, which, stage == 1 ? 3 : 0)[c]); }
        V[i] = v;
    }
    __syncthreads();
    f32x4 xa[8]; v2u ya[8];
#define LN_LOAD(rr, X, Y) do { const float* xin_ = (stage == 1 && l == 0) ? ((rr) < LC ? P.in[I_CTX] + (size_t)(rr) * DM : P.in[I_X] + (size_t)((rr) - LC) * DM) : xrow(P, (rr)); const bf16* ad_ = ADD + (size_t)(rr) * DM; \
        _Pragma("unroll") for (int j = 0; j < 8; ++j) { const int col_ = 4 * lane + 256 * j; X[j] = *(const f32x4*)(xin_ + col_); \
            if (l == 0 && (rr) < LC) { const float* sp_ = SLAB + (size_t)(rr) * DM + col_; f32x4 a_ = *(const f32x4*)sp_; _Pragma("unroll") for (int s_ = 1; s_ < KSPLIT_D; ++s_) if (s_ < (stage == 1 ? KSPLIT_O : KSPLIT_D)) a_ += *(const f32x4*)(sp_ + (size_t)s_ * 256 * DM); \
                v2u w_; w_.x = pk2(a_[0], a_[1]); w_.y = pk2(a_[2], a_[3]); Y[j] = w_; } else Y[j] = *(const v2u*)(ad_ + col_); } } while (0)
    int r = r_lo + gw;
    if (r < MT) LN_LOAD(r, xa, ya);
    while (r < MT) {
        const int rn = r + NGW; f32x4 xb[8]; v2u yb[8];
#pragma unroll
        for (int j = 0; j < 8; ++j) { xb[j] = (f32x4){0.f, 0.f, 0.f, 0.f}; yb[j] = (v2u){0u, 0u}; }
        if (rn < MT) LN_LOAD(rn, xb, yb);
        const int which = r < LC; const float* gt = V + (which ? 5 : 0) * DM; const float* scv = V + (which ? 6 : 1) * DM; const float* shv = V + (which ? 7 : 2) * DM;
        float* xo = xrow(P, r);
        f32x4 v[8]; float s = 0.f;
#pragma unroll
        for (int j = 0; j < 8; ++j) { const int col = 4 * lane + 256 * j; const f32x4 g4 = *(const f32x4*)(gt + col);
            const f32x4 a = {bflo(ya[j].x), bfhi(ya[j].x), bflo(ya[j].y), bfhi(ya[j].y)};
            v[j] = xa[j] * ALPHA + g4 * a; s += (v[j][0] + v[j][1]) + (v[j][2] + v[j][3]); }
        const float mean = wave_sum(s, lane) * (1.0f / DM); float s2 = 0.f;
#pragma unroll
        for (int j = 0; j < 8; ++j) { v[j] = v[j] - mean; s2 += (v[j][0] * v[j][0] + v[j][1] * v[j][1]) + (v[j][2] * v[j][2] + v[j][3] * v[j][3]); }
        const float rstd = 1.0f / sqrtf(wave_sum(s2, lane) * (1.0f / DM) + LN_EPS);
#pragma unroll
        for (int j = 0; j < 8; ++j) { const int col = 4 * lane + 256 * j; const f32x4 gg = *(const f32x4*)(V + 3 * DM + col), bb = *(const f32x4*)(V + 4 * DM + col);
            const f32x4 o = v[j] * rstd * gg + bb; *(f32x4*)(xo + col) = o;
            if (write_h) { const f32x4 s4 = *(const f32x4*)(scv + col), t4 = *(const f32x4*)(shv + col); const f32x4 hv = o * (s4 + 1.0f) + t4;
                v2u w; w.x = pk2(hv[0], hv[1]); w.y = pk2(hv[2], hv[3]); *(v2u*)(HN + (size_t)r * DM + col) = w; } }
#pragma unroll
        for (int j = 0; j < 8; ++j) { xa[j] = xb[j]; ya[j] = yb[j]; }
        r = rn;
    }
#undef LN_LOAD
    __syncthreads();
}
__device__ __forceinline__ void ph_conv(const Params& P, int l, int gtid, int NTH) {
    const bf16* UP = (const bf16*)(P.ws + WS_R1); bf16* ACT = (bf16*)(P.ws + WS_R2);
    const float* cw = P.in[I_CONVW] + (size_t)l * 3 * DFF; const float* cb = P.in[I_CONVB] + (size_t)l * DFF;
    constexpr int NCG = DFF / 8, RS = 8, NSTRIP = MT / RS;
    const int s_lo = (l == NLAYER - 1) ? LC / RS : 0;
    for (int it = s_lo * NCG + gtid; it < NSTRIP * NCG; it += NTH) {
        const int cgi = it % NCG, strip = it / NCG, ch = cgi * 8, r0 = strip * RS;
        const bool hasprev = (r0 != 0) && (r0 != LC), hasnext = (r0 + RS != LC) && (r0 + RS != MT);
        v4u g[RS + 2], u[RS];
        g[0] = (v4u){0u, 0u, 0u, 0u}; g[RS + 1] = (v4u){0u, 0u, 0u, 0u};
        if (hasprev) g[0] = *(const v4u*)(UP + (size_t)(r0 - 1) * NUP + ch);
#pragma unroll
        for (int i = 0; i < RS; ++i) { g[i + 1] = *(const v4u*)(UP + (size_t)(r0 + i) * NUP + ch); u[i] = *(const v4u*)(UP + (size_t)(r0 + i) * NUP + DFF + ch); }
        if (hasnext) g[RS + 1] = *(const v4u*)(UP + (size_t)(r0 + RS) * NUP + ch);
        float w0[8], w1[8], w2[8], bb[8];
#pragma unroll
        for (int e = 0; e < 8; ++e) { w0[e] = cw[ch + e]; w1[e] = cw[DFF + ch + e]; w2[e] = cw[2 * DFF + ch + e]; bb[e] = cb[ch + e]; }
#pragma unroll
        for (int i = 0; i < RS; ++i) { v4u o;
#pragma unroll
            for (int e = 0; e < 4; ++e) {
                const float ga = bflo(g[i][e]) * w0[2 * e] + bflo(g[i + 1][e]) * w1[2 * e] + bflo(g[i + 2][e]) * w2[2 * e] + bb[2 * e];
                const float gb = bfhi(g[i][e]) * w0[2 * e + 1] + bfhi(g[i + 1][e]) * w1[2 * e + 1] + bfhi(g[i + 2][e]) * w2[2 * e + 1] + bb[2 * e + 1];
                const float sa = ga / (1.0f + __expf(-ga)), sb = gb / (1.0f + __expf(-gb));
                o[e] = pk2(sa * bflo(u[i][e]), sb * bfhi(u[i][e]));
            }
            *(v4u*)(ACT + (size_t)(r0 + i) * DFF + ch) = o; }
    }
}
__device__ __forceinline__ void ph_attn(const Params& P, int l, unsigned char* lds, int vcu, int G) {
    const bf16* proj = (const bf16*)(P.ws + WS_R1); float* T = (float*)(P.ws + WS_R1 + R1_T); bf16* AO = (bf16*)(P.ws + WS_R2 + R2_B);
    const int n_units = 512 + 512 + (l == 0 ? 16 : 0);
#pragma unroll 1
    for (int u = vcu; u < n_units; u += G) {
        att::Unit U;
        U.Of = nullptr; U.Ob = nullptr; U.natab = nullptr; U.na = 0; U.qrow0 = 0; U.kr0 = 0; U.base1 = 0;
        int kind = 0;
        if (u < 512) {
            const int hc = u >> 6, qb = u & 63, h = hc >> 1, c = hc & 1; const size_t q0 = (size_t)(LC + qb * 256);
            U.Q = proj + q0 * IN_DIM + h * 256 + c * 128; U.K = proj + 1024 + h * 256 + c * 128; U.V = proj + 2048 + h * 256;
            U.Of = T + q0 * DM + h * 512 + c * 256; U.nt = MT / 64; U.nsplit = MT / 64;
        } else if (u < 1024) {
            const int un = u - 512, h = un >> 6, qb = un & 63; const size_t q0 = (size_t)(LC + qb * 256);
            int start = 4 * qb - 4; start = start < 0 ? 0 : (start > 244 ? 244 : start);
            U.Q = proj + q0 * IN_DIM + 3072 + h * 128; U.K = proj + 4096 + h * 128; U.V = proj + 5120 + h * 128;
            U.Ob = AO + q0 * DM + 1024 + h * 128; U.nt = 16; U.nsplit = 4; U.base1 = LC + start * 64; U.na = 1; U.qrow0 = 4 * qb; U.kr0 = start;
            U.natab = (const float*)(P.ws + WS_NATAB) + (size_t)(l * 8 + h) * NATAB_N; kind = 2;
        } else {
            const int v = u - 1024;
            if (v < 8) { const int h = v >> 1, c = v & 1;
                U.Q = proj + h * 256 + c * 128; U.K = proj + 1024 + h * 256 + c * 128; U.V = proj + 2048 + h * 256; U.Of = T + h * 512 + c * 256; }
            else { const int h = v - 8; U.Q = proj + 3072 + h * 128; U.K = proj + 4096 + h * 128; U.V = proj + 5120 + h * 128; U.Ob = AO + 1024 + h * 128; kind = 1; }
            U.nt = 4; U.nsplit = 4;
        }
        if (kind == 0) att::unit_body_da(U, (char*)lds); else if (kind == 2) att::unit_body_v128<true>(U, (char*)lds); else att::unit_body_v128<false>(U, (char*)lds);
    }
}

#define XB_TMO      128
#define XB_XCNT(j)  (256  + 64 * (j))
#define XB_XSUB(j)  (1280 + 64 * (j))
#define XB_XGEN(j)  (2304 + 64 * (j))
#define XB_TOP      3328
#define XB_TOPGEN   3392
#define XCD_BAR_WORDS 3456
#define XB_SPIN_CAP (1u << 18)

__device__ __forceinline__ unsigned xb_ld(unsigned* p)              { return __hip_atomic_load(p, __ATOMIC_RELAXED, __HIP_MEMORY_SCOPE_AGENT); }
__device__ __forceinline__ unsigned xb_add(unsigned* p, unsigned v) { return __hip_atomic_fetch_add(p, v, __ATOMIC_RELAXED, __HIP_MEMORY_SCOPE_AGENT); }
__device__ __forceinline__ unsigned xb_xcc_id() { return (unsigned)__builtin_amdgcn_s_getreg((3 << 11) | 20) & 0xFu; }
#define XB_SPIN(cond, bar) do { unsigned _sp = 0; while (cond) { __builtin_amdgcn_s_sleep(1); \
    if ((++_sp & 255u) == 0u) { if (xb_ld(&(bar)[XB_TMO])) break; if (_sp > XB_SPIN_CAP) { atomicAdd(&(bar)[XB_TMO], 1u); break; } } } } while (0)

struct XcdBarrier {
    unsigned* bar; unsigned x;
    volatile LAS unsigned* st;
};

__device__ __forceinline__ XcdBarrier xcd_barrier_post(unsigned* bar, volatile LAS unsigned* st) {
    XcdBarrier b; b.bar = bar; b.x = xb_xcc_id(); b.st = st;
    if (threadIdx.x == 0) (void)xb_add(&bar[XB_XCNT(b.x)], 1u);
    return b;
}
__device__ __forceinline__ void xcd_barrier_complete(unsigned* bar, unsigned x, unsigned& nloc, unsigned& nx) {
    const unsigned G = gridDim.x * gridDim.y * gridDim.z;
    unsigned sum, cnt, mine, sp = 0u;
    for (;;) {
        sum = 0u; cnt = 0u; mine = 0u;
#pragma unroll
        for (unsigned j = 0; j < 16; ++j) { const unsigned c = xb_ld(&bar[XB_XCNT(j)]); sum += c; cnt += (c > 0u) ? 1u : 0u; mine = (j == x) ? c : mine; }
        if (sum == G) break;
        __builtin_amdgcn_s_sleep(1);
        if ((++sp & 255u) == 0u) { if (xb_ld(&bar[XB_TMO])) break; if (sp > XB_SPIN_CAP) { atomicAdd(&bar[XB_TMO], 1u); break; } }
    }
    nloc = mine > 0u ? mine : 1u; nx = cnt > 0u ? cnt : 1u;
}

__device__ __forceinline__ void xcd_barrier(const XcdBarrier& b) {
    asm volatile("s_waitcnt vmcnt(0)" ::: "memory");
    __syncthreads();
    if (threadIdx.x == 0) {
        unsigned* bar = b.bar;
        __builtin_amdgcn_s_waitcnt(0);
        unsigned nloc = b.st[0], nx = b.st[1];
        if (nloc == 0u) { xcd_barrier_complete(bar, b.x, nloc, nx); b.st[0] = nloc; b.st[1] = nx; }
        const unsigned old = xb_add(&bar[XB_XSUB(b.x)], 1u);
        const unsigned gen = old / nloc;
        if (old + 1u == (gen + 1u) * nloc) {
            __builtin_amdgcn_fence(__ATOMIC_RELEASE, "agent");
            asm volatile("s_waitcnt vmcnt(0)" ::: "memory");
            const unsigned og = xb_add(&bar[XB_TOP], 1u);
            const unsigned tg = og / nx;
            if (og + 1u == (tg + 1u) * nx) xb_add(&bar[XB_TOPGEN], 1u);
            else XB_SPIN(xb_ld(&bar[XB_TOPGEN]) == tg, bar);
            __builtin_amdgcn_fence(__ATOMIC_ACQUIRE, "agent");
            xb_add(&bar[XB_XGEN(b.x)], 1u);
            asm volatile("s_waitcnt vmcnt(0)" ::: "memory");
        } else {
            XB_SPIN(xb_ld(&bar[XB_XGEN(b.x)]) == gen, bar);
            __builtin_amdgcn_fence(__ATOMIC_ACQUIRE, "agent");
            asm volatile("s_waitcnt vmcnt(0)" ::: "memory");
        }
    }
    __syncthreads();
}
constexpr int LDS_BYTES = 135168;
static_assert(att::SHM_ATTN <= 131072 && att::SHM_DA <= 131072 && pg8::STAGE_BYTES == 131072, "LDS map");

constexpr int NPHASES = 3 + NLAYER * 9;
__global__ void __launch_bounds__(512) mega_fwd(Params P) {
    extern __shared__ __attribute__((aligned(16))) unsigned char lds[];
    cg::grid_group grid = cg::this_grid();
    { volatile LAS unsigned* st_ = (volatile LAS unsigned*)((LAS unsigned char*)lds + 131072); if (threadIdx.x < 16) st_[threadIdx.x] = 0u; }
    __syncthreads();
    const XcdBarrier xbar = xcd_barrier_post((unsigned*)(P.ws + WS_BAR), (volatile LAS unsigned*)((LAS unsigned char*)lds + 131072));
    const int G = gridDim.x, bx = blockIdx.x;
#define VCU ((G % 8 == 0) ? (bx % 8) * (G / 8) + bx / 8 : bx)
    int ph = 0;
#define NGW (G * 8)
#define NTH (G * 512)
#define RUN(body) do { { int tid = threadIdx.x; asm volatile("" : "+v"(tid)); const int lane = tid & 63, wave = __builtin_amdgcn_readfirstlane(tid >> 6), gw = bx * 8 + wave, gtid = bx * 512 + tid; (void)lane; (void)gw; (void)gtid; body; } if (ph + 1 < NPHASES) { if (G < 0) grid.sync(); else xcd_barrier(xbar); } ++ph; } while (0)
#define GEMM(Aptr, Wptr, Optr, M_, N_, K_) do { pg8::Gemm g{(const pg8::bf16_t*)(Aptr), (const pg8::bf16_t*)(Wptr), (M_), (N_), (K_), (K_)}; pg8::StaticOrder S; S.init((M_), (N_), G, bx); \
        pg8::EpiBf16 E{(pg8::bf16_t*)(Optr), (N_)}; pg8::gemm_phase<pg8::EpiBf16, pg8::StaticOrder, true, true>((PG8_LAS unsigned char*)lds, g, S, E); } while (0)
      \
#define GEMM_CTX(Aptr, Wptr, SLAB, N_, K_, S_) do { const int nun_ = ((N_) / 256) * (S_); const bool has_ = bx < nun_; const int pn_ = has_ ? bx / (S_) : 0, sp_ = has_ ? bx % (S_) : 0; constexpr int Kc_ = (K_) / (S_); \
        pg8::Gemm g{(const pg8::bf16_t*)(Aptr) + sp_ * Kc_, (const pg8::bf16_t*)(Wptr) + sp_ * Kc_, 256, (N_), Kc_, (K_)}; pg8::OneUnit S{pn_, has_}; \
        pg8::EpiF32 E{(float*)(SLAB), (N_), sp_}; pg8::gemm_phase<pg8::EpiF32, pg8::OneUnit, false, true>((PG8_LAS unsigned char*)lds, g, S, E); } while (0)
#define GEMM_PROJ(Aptr, Wptr, Optr) do { pg8::Gemm g{(const pg8::bf16_t*)(Aptr), (const pg8::bf16_t*)(Wptr), MT, IN_DIM, DM, DM}; pg8::StaticOrder S; S.init(MT, IN_DIM, G, bx); \
        pg8::EpiProj E{(pg8::bf16_t*)(Optr), IN_DIM, (const float*)(P.ws + WS_ROPE)}; pg8::gemm_phase<pg8::EpiProj, pg8::StaticOrder, true, true>((PG8_LAS unsigned char*)lds, g, S, E); } while (0)
#ifndef SKIP_PRO
    RUN(ph_prologue(P, lds, tid, lane, wave, G));
#endif
    RUN(ph_modreduce(P, gtid, NTH));
    RUN(ph_modulate0(P, gw, NGW, lane));
    {
        constexpr int l = 0; constexpr bool last = (l == NLAYER - 1);
        constexpr size_t ro = LC;
        const size_t ru = last ? (size_t)LC : 0; const int Mu = last ? SEQL : MT;
#define wl (P.ws + WS_W + (size_t)l * W_LAYER)
        RUN(GEMM_PROJ(P.ws + WS_R2, wl + W_IN, P.ws + WS_R1));
        RUN(ph_attn(P, l, lds, VCU, G));
        RUN(ph_combine(P, l, gw, NGW, lane));
        RUN(GEMM(P.ws + WS_R2 + R2_B + ro * DM * 2, wl + W_O, P.ws + WS_R2 + ro * DM * 2, SEQL, DM, DM); if (!last) GEMM_CTX(P.ws + WS_R2 + R2_B, wl + W_O, P.ws + WS_SLAB_O, DM, DM, KSPLIT_O));
        RUN(ph_ln(P, l, 1, lds, tid, gw, NGW, lane));
        RUN(GEMM(P.ws + WS_R2 + R2_B + ru * DM * 2, wl + W_UP, P.ws + WS_R1 + ru * NUP * 2, Mu, NUP, DM));
        RUN(ph_conv(P, l, gtid, NTH));
        RUN(GEMM(P.ws + WS_R2 + ro * DFF * 2, wl + W_DN, P.ws + WS_R1 + ro * DM * 2, SEQL, DM, DFF); if (!last) GEMM_CTX(P.ws + WS_R2, wl + W_DN, P.ws + WS_SLAB_D, DM, DFF, KSPLIT_D));
        RUN(ph_ln(P, l, 2, lds, tid, gw, NGW, lane));
    }
    {
        constexpr int l = 1; constexpr bool last = (l == NLAYER - 1);
        constexpr size_t ro = LC;
        const size_t ru = last ? (size_t)LC : 0; const int Mu = last ? SEQL : MT;
        RUN(GEMM_PROJ(P.ws + WS_R2, wl + W_IN, P.ws + WS_R1));
        RUN(ph_attn(P, l, lds, VCU, G));
        RUN(ph_combine(P, l, gw, NGW, lane));
        RUN(GEMM(P.ws + WS_R2 + R2_B + ro * DM * 2, wl + W_O, P.ws + WS_R2 + ro * DM * 2, SEQL, DM, DM); if (!last) GEMM_CTX(P.ws + WS_R2 + R2_B, wl + W_O, P.ws + WS_SLAB_O, DM, DM, KSPLIT_O));
        RUN(ph_ln(P, l, 1, lds, tid, gw, NGW, lane));
        RUN(GEMM(P.ws + WS_R2 + R2_B + ru * DM * 2, wl + W_UP, P.ws + WS_R1 + ru * NUP * 2, Mu, NUP, DM));
        RUN(ph_conv(P, l, gtid, NTH));
        RUN(GEMM(P.ws + WS_R2 + ro * DFF * 2, wl + W_DN, P.ws + WS_R1 + ro * DM * 2, SEQL, DM, DFF); if (!last) GEMM_CTX(P.ws + WS_R2, wl + W_DN, P.ws + WS_SLAB_D, DM, DFF, KSPLIT_D));
        RUN(ph_ln(P, l, 2, lds, tid, gw, NGW, lane));
    }
#undef RUN
#undef wl
#undef GEMM
#undef GEMM_PROJ
#undef VCU
#undef NGW
#undef NTH
}

extern "C" void kernel_launch(void* const* d_in, const int* in_sizes, int n_in, void* d_out, int out_size, void* d_ws, size_t ws_size, hipStream_t stream) {
    static int grid = 0;
    if (grid == 0) {
        if (n_in != 19 || in_sizes[0] != SEQL * DM || out_size != SEQL * DM || ws_size < WS_END) { fprintf(stderr, "kernel_launch: shape/workspace mismatch (n_in %d, ws %zu < %zu)\n", n_in, ws_size, (size_t)WS_END); grid = -1; return; }
        int dev = 0, cus = 0, per_cu = 0;
        if (hipGetDevice(&dev) != hipSuccess || hipDeviceGetAttribute(&cus, hipDeviceAttributeMultiprocessorCount, dev) != hipSuccess) { grid = -1; return; }
        if (hipFuncSetAttribute((const void*)mega_fwd, hipFuncAttributeMaxDynamicSharedMemorySize, LDS_BYTES) != hipSuccess) { fprintf(stderr, "kernel_launch: hipFuncSetAttribute failed\n"); grid = -1; return; }
        if (hipOccupancyMaxActiveBlocksPerMultiprocessor(&per_cu, (const void*)mega_fwd, 512, LDS_BYTES) != hipSuccess || per_cu < 1) { fprintf(stderr, "kernel_launch: occupancy query says %d\n", per_cu); per_cu = 1; }
        (void)hipGetLastError();
        grid = cus * 1;
    }
    if (grid < 0) return;
    if (hipMemsetAsync((char*)d_ws + WS_BAR, 0, 16384 + 8 * 64 * 4, stream) != hipSuccess) { fprintf(stderr, "kernel_launch: memset failed\n"); return; }
    Params p{};
    for (int i = 0; i < 19; ++i) p.in[i] = (const float*)d_in[i];
    p.out = (float*)d_out; p.ws = (unsigned char*)d_ws;
    void* args[] = {&p};
    hipError_t e = hipLaunchCooperativeKernel((const void*)mega_fwd, dim3(grid), dim3(512), args, LDS_BYTES, stream);
    if (e != hipSuccess) fprintf(stderr, "kernel_launch: cooperative launch failed: %s (grid %d)\n", hipGetErrorString(e), grid);
}
```

```cpp
#include <hip/hip_runtime.h>
#include <hip/hip_bf16.h>
#include <hip/hip_cooperative_groups.h>
#include <cstdio>
#include <cstdint>
#include <cmath>
namespace cg = cooperative_groups;
namespace pg8 {
#define PG8_LAS __attribute__((address_space(3)))
typedef unsigned short bf16_t;
typedef short bf16x8 __attribute__((ext_vector_type(8)));
typedef float f32x4 __attribute__((ext_vector_type(4)));
typedef unsigned u32x4 __attribute__((ext_vector_type(4)));
constexpr int BM = 256, BK = 64, HALF = 128, HTB = HALF * BK * 2  , STAGE_BYTES = 8 * HTB, NXCD = 8, WGM = 8;

__host__ __device__ __forceinline__ int lds_byte(int r, int c) { const int st = (r >> 4) * 2 + (c >> 5), rr = r & 15, cc = c & 31, ob = rr * 64 + cc * 2; return st * 1024 + (ob ^ (((ob >> 9) & 1) << 5)); }
__host__ __device__ __forceinline__ void stage_rc(int b, int& R, int& C) { const int st = b / 1024, sb = b % 1024, swz = sb ^ (((sb >> 9) & 1) << 5); R = (st >> 1) * 16 + swz / 64; C = (st & 1) * 32 + (swz % 64) / 2; }
__host__ __device__ __forceinline__ int perm32(int rho) { const int n = rho >> 4, i = rho & 15; return 8 * (i >> 2) + 4 * n + (i & 3); }

struct Unit { int pm, pn; };
struct Gemm { const bf16_t* A; const bf16_t* Bt; int M, N, K, ld; };

struct StaticOrder {
    int nM, nN, nwg, G, c;
    __host__ __device__ void init(int M, int N, int G_, int c_) { nM = M / BM; nN = N / BM; nwg = nM * nN; G = G_; c = c_; }
    __host__ __device__ bool next(int i, Unit& u) const {
        const long L = (long)i * G + c; if (L >= nwg) return false;
        int wgid = (int)L; { const int q = nwg / NXCD, r = nwg % NXCD, xcd = wgid % NXCD, off = wgid / NXCD; wgid = (xcd < r ? xcd * (q + 1) : r * (q + 1) + (xcd - r) * q) + off; }
        const int nig = WGM * nN, gid = wgid / nig, fm = gid * WGM, gsz = (nM - fm) < WGM ? (nM - fm) : WGM;
        u.pm = fm + ((wgid % nig) % gsz); u.pn = (wgid % nig) / gsz; return true;
    }
    __device__ __forceinline__ void a_ready(const Unit&) const {}
    __device__ __forceinline__ void done(const Unit&) const {}
};

__device__ __forceinline__ unsigned cvt_pk_bf16(float lo, float hi) { unsigned r; asm volatile("v_cvt_pk_bf16_f32 %0, %1, %2" : "=v"(r) : "v"(lo), "v"(hi)); return r; }
typedef float f32x2 __attribute__((ext_vector_type(2)));
struct EpiBf16 {
    static constexpr bool PERM = true, AFTER_DRAIN = false;
    bf16_t* O; int ldc;
    __device__ __forceinline__ void operator()(const f32x4 (&acc)[2][2][4][2], const Unit& u, int wr, int wc, int fr, int fq) const {
        const int row0 = u.pm * BM + wr * 64 + fr; const int col0 = u.pn * BM + wc * 32 + 8 * fq;
#pragma unroll
        for (int ai = 0; ai < 2; ++ai)
#pragma unroll
            for (int m = 0; m < 4; ++m) { bf16_t* rowp = O + (size_t)(row0 + ai * HALF + m * 16) * ldc + col0;
#pragma unroll
                for (int bj = 0; bj < 2; ++bj) { const f32x4 v0 = acc[ai][bj][m][0], v1 = acc[ai][bj][m][1];
                    u32x4 w; w.x = cvt_pk_bf16(v0[0], v0[1]); w.y = cvt_pk_bf16(v0[2], v0[3]); w.z = cvt_pk_bf16(v1[0], v1[1]); w.w = cvt_pk_bf16(v1[2], v1[3]);
                    *(u32x4*)(rowp + bj * HALF) = w; } }
    }
    __device__ __forceinline__ void fused(f32x4 (&)[2][2][4][2], const Unit&, int, int, int, int, PG8_LAS unsigned char*, int, int) const {}
};

struct OneUnit {
    int pn; bool has;
    __device__ bool next(int i, Unit& u) const { if (i != 0 || !has) return false; u.pm = 0; u.pn = pn; return true; }
    __device__ __forceinline__ void a_ready(const Unit&) const {}
    __device__ __forceinline__ void done(const Unit&) const {}
};
struct EpiF32 {
    static constexpr bool PERM = true, AFTER_DRAIN = false;
    float* slab; int N, split;
    __device__ __forceinline__ void operator()(const f32x4 (&acc)[2][2][4][2], const Unit& u, int wr, int wc, int fr, int fq) const {
        const int row0 = wr * 64 + fr, col0 = u.pn * BM + wc * 32 + 8 * fq;
        float* sl = slab + (size_t)split * 256 * N;
#pragma unroll
        for (int ai = 0; ai < 2; ++ai)
#pragma unroll
            for (int m = 0; m < 4; ++m) { float* rowp = sl + (size_t)(row0 + ai * HALF + m * 16) * N + col0;
#pragma unroll
                for (int bj = 0; bj < 2; ++bj) { *(f32x4*)(rowp + bj * HALF) = acc[ai][bj][m][0]; *(f32x4*)(rowp + bj * HALF + 4) = acc[ai][bj][m][1]; } }
    }
    __device__ __forceinline__ void fused(f32x4 (&)[2][2][4][2], const Unit&, int, int, int, int, PG8_LAS unsigned char*, int, int) const {}
};

struct EpiProj {
    static constexpr bool PERM = true, AFTER_DRAIN = false;
    bf16_t* O; int ldc; const float* tab;
    __device__ __forceinline__ void operator()(const f32x4 (&acc)[2][2][4][2], const Unit& u, int wr_, int wc_, int fr_, int fq_) const {
        int t_ = threadIdx.x; asm volatile("" : "+v"(t_));
        const int wid_ = t_ >> 6, lane_ = t_ & 63, wr = wid_ >> 2, wc = wid_ & 3, fr = lane_ & 15, fq = lane_ >> 4; (void)wr_; (void)wc_; (void)fr_; (void)fq_;
        const int row0 = u.pm * BM + wr * 64 + fr;
        if (u.pn >= 8) {
            const int col0 = u.pn * BM + wc * 32 + 8 * fq;
#pragma unroll
            for (int ai = 0; ai < 2; ++ai)
#pragma unroll
                for (int m = 0; m < 4; ++m) { bf16_t* rowp = O + (size_t)(row0 + ai * HALF + m * 16) * ldc + col0;
#pragma unroll
                    for (int bj = 0; bj < 2; ++bj) { const f32x4 v0 = acc[ai][bj][m][0], v1 = acc[ai][bj][m][1];
                        u32x4 w; w.x = cvt_pk_bf16(v0[0], v0[1]); w.y = cvt_pk_bf16(v0[2], v0[3]); w.z = cvt_pk_bf16(v1[0], v1[1]); w.w = cvt_pk_bf16(v1[2], v1[3]);
                        *(u32x4*)(rowp + bj * HALF) = w; } }
            return;
        }
        typedef unsigned u32x2 __attribute__((ext_vector_type(2)));
        const int p = wc >> 1, i0 = ((wc & 1) * 4 + fq) * 4; const bool rope = u.pm >= 1;
#pragma unroll
        for (int ai = 0; ai < 2; ++ai)
#pragma unroll
            for (int m = 0; m < 4; ++m) { const int row = row0 + ai * HALF + m * 16; const int t = row - 256;
                f32x4 c01 = {1.f, 0.f, 1.f, 0.f}, c23 = {1.f, 0.f, 1.f, 0.f};
                if (rope) { const float* tb = tab + ((size_t)(p ? 256 + (t & 63) : (t >> 6)) * 32 + i0) * 2; c01 = *(const f32x4*)tb; c23 = *(const f32x4*)(tb + 4); }
                bf16_t* rowp = O + (size_t)row * ldc + u.pn * BM + p * 64 + i0;
#pragma unroll
                for (int bj = 0; bj < 2; ++bj) { const f32x4 x1 = acc[ai][bj][m][0], x2 = acc[ai][bj][m][1];
                    u32x2 a, b;
                    a.x = cvt_pk_bf16(x1[0] * c01[0] - x2[0] * c01[1], x1[1] * c01[2] - x2[1] * c01[3]); a.y = cvt_pk_bf16(x1[2] * c23[0] - x2[2] * c23[1], x1[3] * c23[2] - x2[3] * c23[3]);
                    b.x = cvt_pk_bf16(x2[0] * c01[0] + x1[0] * c01[1], x2[1] * c01[2] + x1[1] * c01[3]); b.y = cvt_pk_bf16(x2[2] * c23[0] + x1[2] * c23[1], x2[3] * c23[2] + x1[3] * c23[3]);
                    *(u32x2*)(rowp + bj * HALF) = a; *(u32x2*)(rowp + bj * HALF + 32) = b; } }
    }
    __device__ __forceinline__ void fused(f32x4 (&)[2][2][4][2], const Unit&, int, int, int, int, PG8_LAS unsigned char*, int, int) const {}
};
template <class Epi, class Sched, bool ALIGN_EPI = false, bool SP2 = false>
__device__ __forceinline__ void gemm_phase(PG8_LAS unsigned char* lds, const Gemm g, const Sched& S, const Epi& E) {
    int tid = threadIdx.x; asm volatile("" : "+v"(tid));
    const int wid = __builtin_amdgcn_readfirstlane(tid >> 6), lane = tid & 63, wr = wid >> 2, wc = wid & 3, fr = lane & 15, fq = lane >> 4;
    const int K = g.ld, nt = g.K / BK;
    unsigned voffA[2], voffB[2];
#pragma unroll
    for (int i = 0; i < 2; ++i) { int R, C; stage_rc(tid * 16 + i * 8192, R, C); const int Rb = Epi::PERM ? ((R & ~31) + perm32(R & 31)) : R;
        voffA[i] = (unsigned)(R * K + C) * 2u; voffB[i] = (unsigned)(Rb * K + C) * 2u; }
    const size_t kstep = (size_t)(BK * 2);
    const size_t hstep = (size_t)HALF * K * 2;
    const size_t tstep = 2 * hstep;
    const unsigned ldsw = (unsigned)wid * 1024u;
    const int aoff = lds_byte(wr * 64 + fr, fq * 8), boff = lds_byte(wc * 32 + fr, fq * 8);
#define PG8_SA(b, h) (((b) * 2 + (h)) * HTB)
#define PG8_SB(b, h) ((4 + (b) * 2 + (h)) * HTB)
#define PG8_STAGE(bufoff, gbase, voff) do { _Pragma("unroll") for (int _i = 0; _i < 2; ++_i) \
        __builtin_amdgcn_global_load_lds((const unsigned*)((const char*)(gbase) + (voff)[_i]), (PG8_LAS unsigned*)(lds + (bufoff) + ldsw + _i * 8192), 16, 0, 0); } while (0)
#define PG8_LDA(dst, b, h) do { _Pragma("unroll") for (int m = 0; m < 4; ++m) _Pragma("unroll") for (int k = 0; k < 2; ++k) dst[m][k] = *(const PG8_LAS bf16x8*)(lds + PG8_SA(b, h) + aoff + m * 2048 + k * 1024); } while (0)
#define PG8_LDB(dst, b, h) do { _Pragma("unroll") for (int n = 0; n < 2; ++n) _Pragma("unroll") for (int k = 0; k < 2; ++k) dst[n][k] = *(const PG8_LAS bf16x8*)(lds + PG8_SB(b, h) + boff + n * 2048 + k * 1024); } while (0)
#define PG8_MMA(ai, bj, At, Bt) do { __builtin_amdgcn_s_setprio(1); _Pragma("unroll") for (int m = 0; m < 4; ++m) _Pragma("unroll") for (int n = 0; n < 2; ++n) _Pragma("unroll") for (int k = 0; k < 2; ++k) \
        acc[ai][bj][m][n] = __builtin_amdgcn_mfma_f32_16x16x32_bf16(Bt[n][k], At[m][k], acc[ai][bj][m][n], 0, 0, 0); __builtin_amdgcn_s_setprio(0); } while (0)
#define PG8_WAIT_V(n) asm volatile("s_waitcnt vmcnt(" #n ")" ::: "memory")
#define PG8_WAIT_L(n) asm volatile("s_waitcnt lgkmcnt(" #n ")" ::: "memory")
#define PG8_BAR __builtin_amdgcn_s_barrier()
#define PG8_SCHED __builtin_amdgcn_sched_barrier(0)
    Unit cur, nxt; int ui = 0;
    if (!S.next(0, cur)) return;
    f32x4 acc[2][2][4][2];
#pragma unroll
    for (int a = 0; a < 2; ++a)
#pragma unroll
        for (int b = 0; b < 2; ++b)
#pragma unroll
            for (int m = 0; m < 4; ++m)
#pragma unroll
                for (int n = 0; n < 2; ++n) acc[a][b][m][n] = (f32x4){0.f, 0.f, 0.f, 0.f};
    bf16x8 At[4][2], B0[2][2], B1[2][2];
    const char* cA = (const char*)g.A + (size_t)cur.pm * tstep; const char* cB = (const char*)g.Bt + (size_t)cur.pn * tstep;
    S.a_ready(cur);
    if constexpr (SP2) {
        PG8_STAGE(PG8_SB(0, 0), cB, voffB); PG8_STAGE(PG8_SB(0, 1), cB + hstep, voffB); PG8_STAGE(PG8_SA(0, 0), cA, voffA); PG8_STAGE(PG8_SA(0, 1), cA + hstep, voffA);
        if (wr == 1) PG8_BAR;
        PG8_WAIT_V(2); PG8_BAR;
        PG8_STAGE(PG8_SB(1, 0), cB + kstep, voffB); PG8_STAGE(PG8_SA(1, 0), cA + kstep, voffA); PG8_STAGE(PG8_SB(1, 1), cB + hstep + kstep, voffB);
        PG8_WAIT_V(6); PG8_BAR;
    } else {
        PG8_STAGE(PG8_SB(0, 0), cB, voffB); PG8_STAGE(PG8_SA(0, 0), cA, voffA); PG8_STAGE(PG8_SB(0, 1), cB + hstep, voffB); PG8_STAGE(PG8_SA(0, 1), cA + hstep, voffA);
        if (wr == 1) PG8_BAR;
        PG8_WAIT_V(4); PG8_BAR;
        PG8_STAGE(PG8_SB(1, 0), cB + kstep, voffB); PG8_STAGE(PG8_SA(1, 0), cA + kstep, voffA); PG8_STAGE(PG8_SB(1, 1), cB + hstep + kstep, voffB);
        PG8_WAIT_V(6); PG8_BAR;
    }
    for (;;) {
        const bool has_next = S.next(ui + 1, nxt);
        const char* nA = has_next ? (const char*)g.A + (size_t)nxt.pm * tstep : cA; const char* nB = has_next ? (const char*)g.Bt + (size_t)nxt.pn * tstep : cB;
        for (int t = 0; t < nt; t += 2) {
            const bool last = (t == nt - 2);
            const char* a1 = cA + (size_t)(t + 1) * kstep;
            const char* a2 = last ? nA : cA + (size_t)(t + 2) * kstep; const char* b2 = last ? nB : cB + (size_t)(t + 2) * kstep;
            const char* a3 = a2 + kstep; const char* b3 = b2 + kstep;
            if (last && has_next) S.a_ready(nxt);
            if constexpr (SP2) {
            PG8_LDB(B0, 0, 0); PG8_LDB(B1, 0, 1); PG8_SCHED; PG8_LDA(At, 0, 0); PG8_STAGE(PG8_SA(1, 1), a1 + hstep, voffA);
            PG8_WAIT_V(8); PG8_WAIT_L(0); PG8_BAR; PG8_MMA(0, 0, At, B0); PG8_MMA(0, 1, At, B1); PG8_BAR; PG8_SCHED;
            PG8_LDA(At, 0, 1); PG8_STAGE(PG8_SB(0, 0), b2, voffB); PG8_STAGE(PG8_SB(0, 1), b2 + hstep, voffB); PG8_STAGE(PG8_SA(0, 0), a2, voffA);
            PG8_WAIT_V(8); PG8_WAIT_L(0); PG8_BAR; PG8_MMA(1, 0, At, B0); PG8_MMA(1, 1, At, B1); PG8_BAR; PG8_SCHED;
            PG8_LDB(B0, 1, 0); PG8_LDB(B1, 1, 1); PG8_SCHED; PG8_LDA(At, 1, 0); PG8_STAGE(PG8_SA(0, 1), a2 + hstep, voffA);
            PG8_WAIT_V(8); PG8_WAIT_L(0); PG8_BAR; PG8_MMA(0, 0, At, B0); PG8_MMA(0, 1, At, B1); PG8_BAR; PG8_SCHED;
            PG8_LDA(At, 1, 1); PG8_STAGE(PG8_SB(1, 0), b3, voffB); PG8_STAGE(PG8_SB(1, 1), b3 + hstep, voffB); PG8_STAGE(PG8_SA(1, 0), a3, voffA);
            PG8_WAIT_V(8); PG8_WAIT_L(0); PG8_BAR; PG8_MMA(1, 0, At, B0); PG8_MMA(1, 1, At, B1); PG8_BAR; PG8_SCHED;
            } else {
            PG8_LDB(B0, 0, 0); PG8_SCHED; PG8_LDA(At, 0, 0); PG8_STAGE(PG8_SA(1, 1), a1 + hstep, voffA);
            PG8_WAIT_L(8); PG8_BAR; PG8_WAIT_L(0); PG8_MMA(0, 0, At, B0); PG8_BAR; PG8_SCHED;
            PG8_LDB(B1, 0, 1); PG8_STAGE(PG8_SB(0, 0), b2, voffB);
            PG8_BAR; PG8_WAIT_L(0); PG8_MMA(0, 1, At, B1); PG8_BAR;
            PG8_LDA(At, 0, 1); PG8_STAGE(PG8_SA(0, 0), a2, voffA);
            PG8_BAR; PG8_WAIT_L(0); PG8_MMA(1, 0, At, B0); PG8_BAR; PG8_SCHED;
            PG8_STAGE(PG8_SB(0, 1), b2 + hstep, voffB);
            PG8_WAIT_V(6); PG8_BAR; PG8_MMA(1, 1, At, B1); PG8_BAR;
            PG8_LDB(B0, 1, 0); PG8_SCHED; PG8_LDA(At, 1, 0); PG8_STAGE(PG8_SA(0, 1), a2 + hstep, voffA);
            PG8_WAIT_L(8); PG8_BAR; PG8_WAIT_L(0); PG8_MMA(0, 0, At, B0); PG8_BAR; PG8_SCHED;
            PG8_LDB(B1, 1, 1); PG8_STAGE(PG8_SB(1, 0), b3, voffB);
            PG8_BAR; PG8_WAIT_L(0); PG8_MMA(0, 1, At, B1); PG8_BAR;
            PG8_LDA(At, 1, 1); PG8_STAGE(PG8_SA(1, 0), a3, voffA);
            PG8_BAR; PG8_WAIT_L(0); PG8_MMA(1, 0, At, B0); PG8_BAR; PG8_SCHED;
            PG8_STAGE(PG8_SB(1, 1), b3 + hstep, voffB);
            PG8_WAIT_V(6); PG8_BAR; PG8_MMA(1, 1, At, B1); PG8_BAR;
            }
        }
        if constexpr (ALIGN_EPI) { if (wr == 0) PG8_BAR; }
        if constexpr (!Epi::AFTER_DRAIN) { E(acc, cur, wr, wc, fr, fq); S.done(cur); }
        if (!has_next) break;
#pragma unroll
        for (int a = 0; a < 2; ++a)
#pragma unroll
            for (int b = 0; b < 2; ++b)
#pragma unroll
                for (int m = 0; m < 4; ++m)
#pragma unroll
                    for (int n = 0; n < 2; ++n) acc[a][b][m][n] = (f32x4){0.f, 0.f, 0.f, 0.f};
        cur = nxt; cA = nA; cB = nB; ++ui;
        if constexpr (ALIGN_EPI) { if (wr == 1) PG8_BAR; }
    }
    PG8_WAIT_V(0);
    if constexpr (!ALIGN_EPI) { if (wr == 0) PG8_BAR; }
    PG8_BAR;
    if constexpr (Epi::AFTER_DRAIN) { E.fused(acc, cur, wr, wc, fr, fq, lds, wid, lane); S.done(cur); }
#undef PG8_SA
#undef PG8_SB
#undef PG8_STAGE
#undef PG8_LDA
#undef PG8_LDB
#undef PG8_MMA
#undef PG8_WAIT_V
#undef PG8_WAIT_L
#undef PG8_BAR
#undef PG8_SCHED
}
}
namespace att {
typedef unsigned short bf16_t;
using bf16x8 = __attribute__((ext_vector_type(8))) short;
using s16x4  = __attribute__((ext_vector_type(4))) short;
using f32x16 = __attribute__((ext_vector_type(16))) float;
using u32x4  = __attribute__((ext_vector_type(4))) unsigned;
using f32x4  = __attribute__((ext_vector_type(4))) float;
constexpr int   D = 128, NW = 8, QBLK = 32, KVBLK = 64;
constexpr float SCALE = 0.088388347648318440f;
constexpr float THR = 8.f;
constexpr int LDP = 6144;
constexpr int LDO = 2048;
constexpr int SHM_V = KVBLK * D * 2, SHM_K = KVBLK * D * 2;
constexpr int SHM_WS_OFF = 2 * SHM_V + 2 * SHM_K, SHM_RPB_OFF = SHM_WS_OFF + NW * 64 * 4, SHM_ATTN = SHM_RPB_OFF + 2048;
constexpr int RPB_N = 15 * 31;

struct Unit {
  const bf16_t* Q; const bf16_t* K; const bf16_t* V;
  float* Of; bf16_t* Ob;
  const float* natab;
  int nt, nsplit, base1;
  int na, qrow0, kr0;
};

#define KSWZ(row, colB) ((row) * 256 + ((colB) ^ (((row) & 7) << 4)))
#define SBAR() __builtin_amdgcn_sched_barrier(0)
__device__ __forceinline__ int crow(int r, int hi) { return (r & 3) + 8 * (r >> 2) + 4 * hi; }
__device__ __forceinline__ unsigned cvtpk(float lo, float hi) { unsigned r; asm volatile("v_cvt_pk_bf16_f32 %0, %1, %2" : "=v"(r) : "v"(lo), "v"(hi)); return r; }
__device__ __forceinline__ bf16x8 ld8(const bf16_t* p) { return *reinterpret_cast<const bf16x8*>(p); }

__device__ __forceinline__ void partialSM(f32x16& p0, f32x16& p1, float& m_reg, float& mn, float& alpha) {
  constexpr float C = SCALE * 1.4426950408889634f;
  float pmax = p0[0];
#pragma unroll
  for (int r = 1; r < 16; ++r) pmax = fmaxf(pmax, p0[r]);
#pragma unroll
  for (int r = 0; r < 16; ++r) pmax = fmaxf(pmax, p1[r]);
  { auto rr = __builtin_amdgcn_permlane32_swap(__float_as_uint(pmax), __float_as_uint(pmax), false, false);
    pmax = fmaxf(__uint_as_float(rr[0]), __uint_as_float(rr[1])); }
  if (__builtin_expect(__all(pmax - m_reg <= THR / SCALE), 1)) { mn = m_reg; alpha = 1.f; }
  else { mn = fmaxf(m_reg, pmax); alpha = __builtin_amdgcn_exp2f((m_reg - mn) * C); m_reg = mn; }
  float mnC = -mn * C;
#pragma unroll
  for (int r = 0; r < 16; ++r) p0[r] = fmaf(p0[r], C, mnC);
#pragma unroll
  for (int r = 0; r < 16; ++r) p1[r] = fmaf(p1[r], C, mnC);
#pragma unroll
  for (int r = 0; r < 16; ++r) p0[r] = __builtin_amdgcn_exp2f(p0[r]);
}
__device__ __forceinline__ void finishSM(f32x16& p0, f32x16& p1, float alpha, float& l_reg, bf16x8& pa0, bf16x8& pa1, bf16x8& pa2, bf16x8& pa3) {
#pragma unroll
  for (int r = 0; r < 16; ++r) p1[r] = __builtin_amdgcn_exp2f(p1[r]);
  float ps = 0;
#pragma unroll
  for (int r = 0; r < 16; ++r) ps += p0[r];
#pragma unroll
  for (int r = 0; r < 16; ++r) ps += p1[r];
  { auto rr = __builtin_amdgcn_permlane32_swap(__float_as_uint(ps), __float_as_uint(ps), false, false);
    ps = __uint_as_float(rr[0]) + __uint_as_float(rr[1]); }
  l_reg = l_reg * alpha + ps;
#define PK4(P, BASE, OUT) do { unsigned a0 = cvtpk(P[BASE + 0], P[BASE + 1]), a1 = cvtpk(P[BASE + 2], P[BASE + 3]);   \
    unsigned b0 = cvtpk(P[BASE + 4], P[BASE + 5]), b1 = cvtpk(P[BASE + 6], P[BASE + 7]);                              \
    auto r0 = __builtin_amdgcn_permlane32_swap(a0, b0, false, false); auto r1 = __builtin_amdgcn_permlane32_swap(a1, b1, false, false); \
    u32x4 w = {r0[0], r1[0], r0[1], r1[1]}; OUT = *reinterpret_cast<bf16x8*>(&w); } while (0)
  PK4(p0, 0, pa0); PK4(p0, 8, pa1); PK4(p1, 0, pa2); PK4(p1, 8, pa3);
#undef PK4
}
__device__ __forceinline__ void qkt(f32x16& p0, f32x16& p1, const bf16_t* Ks, const bf16x8* qr, int r32, int hi) {
#pragma unroll
  for (int d0 = 0; d0 < 8; ++d0) { int cb = (d0 * 16 + hi * 8) * 2;
    bf16x8 b0 = *reinterpret_cast<const bf16x8*>((const char*)Ks + KSWZ(r32, cb));
    bf16x8 b1 = *reinterpret_cast<const bf16x8*>((const char*)Ks + KSWZ(32 + r32, cb));
    p0 = __builtin_amdgcn_mfma_f32_32x32x16_bf16(b0, qr[d0], p0, 0, 0, 0);
    p1 = __builtin_amdgcn_mfma_f32_32x32x16_bf16(b1, qr[d0], p1, 0, 0, 0); }
}
__device__ __forceinline__ int v_st(int k, int c) { const int kk = (k & ~0xC) | ((k & 4) << 1) | ((k & 8) >> 1); return ((kk >> 3) * 4 + (c >> 5)) * 512 + ((kk & 7) * 32 + (c & 31)) * 2; }
__device__ __forceinline__ int v_rd_base(int lane) { return ((lane & 3) << 3) | (((lane >> 2) & 3) << 6) | (((lane >> 4) & 1) << 5) | (((lane >> 5) & 1) << 8); }
constexpr int v_rd_off(int d0, int ks, int half) { return d0 * 512 + ks * 4096 + half * 2048; }
template <int OFF> __device__ __forceinline__ s16x4 tr_read(int vb) {
  s16x4 r; asm volatile("ds_read_b64_tr_b16 %0, %1 offset:%2" : "=&v"(r) : "v"(vb), "i"(OFF) : "memory"); return r;
}
template <int D0> __device__ __forceinline__ void pv_one(f32x16& od, int vb, bf16x8 pa0, bf16x8 pa1, bf16x8 pa2, bf16x8 pa3) {
  const s16x4 l0 = tr_read<v_rd_off(D0, 0, 0)>(vb), h0 = tr_read<v_rd_off(D0, 0, 1)>(vb), l1 = tr_read<v_rd_off(D0, 1, 0)>(vb), h1 = tr_read<v_rd_off(D0, 1, 1)>(vb);
  const s16x4 l2 = tr_read<v_rd_off(D0, 2, 0)>(vb), h2 = tr_read<v_rd_off(D0, 2, 1)>(vb), l3 = tr_read<v_rd_off(D0, 3, 0)>(vb), h3 = tr_read<v_rd_off(D0, 3, 1)>(vb);
  asm volatile("s_waitcnt lgkmcnt(0)" ::: "memory"); SBAR();
#define PK(L, H) (bf16x8){L[0], L[1], L[2], L[3], H[0], H[1], H[2], H[3]}
  od = __builtin_amdgcn_mfma_f32_32x32x16_bf16(pa0, PK(l0, h0), od, 0, 0, 0);
  od = __builtin_amdgcn_mfma_f32_32x32x16_bf16(pa1, PK(l1, h1), od, 0, 0, 0);
  od = __builtin_amdgcn_mfma_f32_32x32x16_bf16(pa2, PK(l2, h2), od, 0, 0, 0);
  od = __builtin_amdgcn_mfma_f32_32x32x16_bf16(pa3, PK(l3, h3), od, 0, 0, 0);
#undef PK
}
__device__ __forceinline__ void pv_d0(f32x16* o, int vb, bf16x8 pa0, bf16x8 pa1, bf16x8 pa2, bf16x8 pa3) {
  pv_one<0>(o[0], vb, pa0, pa1, pa2, pa3); pv_one<1>(o[1], vb, pa0, pa1, pa2, pa3); pv_one<2>(o[2], vb, pa0, pa1, pa2, pa3); pv_one<3>(o[3], vb, pa0, pa1, pa2, pa3);
}
template <bool NA> __device__ __forceinline__ void acc_init(f32x16& p0, f32x16& p1, int j, const Unit& U, int wid, int r32, int hi) {
  if constexpr (!NA) { p0 = f32x16{}; p1 = f32x16{}; }
  else {
    int slice = 16;
    if (j >= U.nsplit) { const int kr = U.kr0 + (j - U.nsplit), qr_ = U.qrow0 + (wid >> 1); int rs = qr_ - 4; rs = rs < 0 ? 0 : (rs > 248 ? 248 : rs);
      slice = (kr >= rs && kr < rs + 8) ? (kr - qr_ + 7) : 15; }
    const float* tb = U.natab + (size_t)slice * 4096 + (unsigned)(((wid & 1) * 32 + r32) * 64 + 4 * hi);
#pragma unroll
    for (int q = 0; q < 4; ++q) { const f32x4 a = *(const f32x4*)(tb + 8 * q), b = *(const f32x4*)(tb + 32 + 8 * q);
      p0[4 * q + 0] = a[0]; p0[4 * q + 1] = a[1]; p0[4 * q + 2] = a[2]; p0[4 * q + 3] = a[3];
      p1[4 * q + 0] = b[0]; p1[4 * q + 1] = b[1]; p1[4 * q + 2] = b[2]; p1[4 * q + 3] = b[3]; }
  }
}

template <bool NA> __device__ __forceinline__ void unit_body(const Unit& U, char* lds) {
  int tid = threadIdx.x; asm volatile("" : "+v"(tid)); const int wid = __builtin_amdgcn_readfirstlane(tid >> 6), lane = tid & 63, r32 = lane & 31, hi = lane >> 5;
  bf16_t* V_lds = (bf16_t*)lds; bf16_t* K_lds = (bf16_t*)(lds + 2 * SHM_V);
  float* ws = (float*)(lds + SHM_WS_OFF) + wid * 64; float* li_l = ws; float* al_l = ws + 32;
  float m_reg = -1e30f, l_reg = 0; f32x16 o[4] = {}; bf16x8 qr[8];
  const bf16_t* Qw = U.Q + (long)(wid * QBLK + r32) * LDP + hi * 8;
#pragma unroll
  for (int d0 = 0; d0 < 8; ++d0) qr[d0] = ld8(Qw + d0 * 16);
  const int sr = tid >> 4, sc = (tid & 15) * 8, vst0 = v_st(sr, sc), vst1 = v_st(32 + sr, sc);
  const int vb0 = (int)(uintptr_t)V_lds + v_rd_base(lane);
  struct { bf16x8 vs0, vs1, ks0, ks1; } sr_[2];
  const int nsplit = U.nsplit, base1 = U.base1;
#define TROW(j_) ((long)((j_) < nsplit ? (j_) * KVBLK : base1 + ((j_) - nsplit) * KVBLK))
#define SLOAD(i, j_) do { const long rb_ = TROW(j_); sr_[i].vs0 = ld8(&U.V[(rb_ + sr) * LDP + sc]); sr_[i].vs1 = ld8(&U.V[(rb_ + 32 + sr) * LDP + sc]); \
    sr_[i].ks0 = ld8(&U.K[(rb_ + sr) * LDP + sc]); sr_[i].ks1 = ld8(&U.K[(rb_ + 32 + sr) * LDP + sc]); } while (0)
#define SWRITE(b, i) do { *(bf16x8*)((char*)V_lds + (b) * SHM_V + vst0) = sr_[i].vs0;          \
    *(bf16x8*)((char*)V_lds + (b) * SHM_V + vst1) = sr_[i].vs1; int kc = sc * 2;               \
    *(bf16x8*)((char*)K_lds + (b) * SHM_K + KSWZ(sr, kc)) = sr_[i].ks0;                       \
    *(bf16x8*)((char*)K_lds + (b) * SHM_K + KSWZ(32 + sr, kc)) = sr_[i].ks1; } while (0)
#define SWAIT() asm volatile("s_waitcnt vmcnt(4)" ::: "memory")
#define RESC(a) do { if (__any((a) < 1.f)) { if (hi == 0) al_l[r32] = (a); asm volatile("s_waitcnt lgkmcnt(0)" ::: "memory"); \
    _Pragma("unroll") for (int d = 0; d < 4; ++d) _Pragma("unroll") for (int r = 0; r < 16; ++r) o[d][r] *= al_l[crow(r, hi)]; } } while (0)
  f32x16 pA0, pA1, pB0, pB1; float mnA, mnB, alA, alB; bf16x8 pa0, pa1, pa2, pa3; const int NT = U.nt;
  constexpr int SE = 0, SO = 1;
  SLOAD(SE, 0); asm volatile("s_waitcnt vmcnt(0)" ::: "memory"); SWRITE(0, SE); __syncthreads();
  acc_init<NA>(pA0, pA1, 0, U, wid, r32, hi); qkt(pA0, pA1, K_lds, qr, r32, hi); partialSM(pA0, pA1, m_reg, mnA, alA);
  SLOAD(SO, 1); if (2 < NT) SLOAD(SE, 2);
  SWAIT(); SWRITE(1, SO); __syncthreads();
  for (int j = 1; j + 1 < NT; j += 2) {
    SBAR(); acc_init<NA>(pB0, pB1, j, U, wid, r32, hi); qkt(pB0, pB1, (bf16_t*)((char*)K_lds + SHM_K), qr, r32, hi);
    finishSM(pA0, pA1, alA, l_reg, pa0, pa1, pa2, pa3); SBAR();
    SLOAD(SO, j + 2); SBAR();
    pv_d0(o, vb0, pa0, pa1, pa2, pa3); partialSM(pB0, pB1, m_reg, mnB, alB);
    __syncthreads(); SWAIT(); SWRITE(0, SE);
    RESC(alB); __syncthreads();
    SBAR(); acc_init<NA>(pA0, pA1, j + 1, U, wid, r32, hi); qkt(pA0, pA1, K_lds, qr, r32, hi);
    finishSM(pB0, pB1, alB, l_reg, pa0, pa1, pa2, pa3); SBAR();
    if (j + 3 < NT) SLOAD(SE, j + 3); SBAR();
    pv_d0(o, vb0 + (int)SHM_V, pa0, pa1, pa2, pa3); partialSM(pA0, pA1, m_reg, mnA, alA);
    __syncthreads(); SWAIT(); SWRITE(1, SO);
    RESC(alA); __syncthreads();
  }
  SBAR(); acc_init<NA>(pB0, pB1, NT - 1, U, wid, r32, hi); qkt(pB0, pB1, (bf16_t*)((char*)K_lds + SHM_K), qr, r32, hi);
  finishSM(pA0, pA1, alA, l_reg, pa0, pa1, pa2, pa3); SBAR();
  pv_d0(o, vb0, pa0, pa1, pa2, pa3); partialSM(pB0, pB1, m_reg, mnB, alB);
  __syncthreads(); RESC(alB);
  finishSM(pB0, pB1, alB, l_reg, pa0, pa1, pa2, pa3); SBAR();
  pv_d0(o, vb0 + (int)SHM_V, pa0, pa1, pa2, pa3);
  if (hi == 0) li_l[r32] = l_reg; asm volatile("s_waitcnt lgkmcnt(0)" ::: "memory");
  float rli[16];
#pragma unroll
  for (int r = 0; r < 16; ++r) rli[r] = __builtin_amdgcn_rcpf(li_l[crow(r, hi)]);
  if (U.Of) {
    float* Ow = U.Of + (long)(wid * QBLK) * LDO;
#pragma unroll
    for (int r = 0; r < 16; ++r) { const int orow = crow(r, hi);
#pragma unroll
      for (int d0 = 0; d0 < 4; ++d0) Ow[(long)orow * LDO + d0 * 32 + r32] = o[d0][r] * rli[r]; }
  } else {
    bf16_t* Ow = U.Ob + (long)(wid * QBLK) * LDO;
#pragma unroll
    for (int r = 0; r < 16; ++r) { const int orow = crow(r, hi);
#pragma unroll
      for (int d0 = 0; d0 < 4; ++d0) Ow[(long)orow * LDO + d0 * 32 + r32] = (bf16_t)(cvtpk(o[d0][r] * rli[r], 0.f) & 0xffffu); }
  }
  __syncthreads();
#undef TROW
#undef SLOAD
#undef SWRITE
#undef SWAIT
#undef RESC
}

constexpr int DA_VB = 32768, DA_KB = 16384, DA_WS_OFF = 2 * DA_VB + 2 * DA_KB, SHM_DA = DA_WS_OFF + NW * 64 * 4;
template <int D0, int KS0> __device__ __forceinline__ void pv_half(f32x16& od, int vb, bf16x8 paA, bf16x8 paB) {
  constexpr int IMG = (D0 >> 2) * 16384, DD = D0 & 3;
  const s16x4 l0 = tr_read<IMG + v_rd_off(DD, KS0, 0)>(vb), h0 = tr_read<IMG + v_rd_off(DD, KS0, 1)>(vb), l1 = tr_read<IMG + v_rd_off(DD, KS0 + 1, 0)>(vb), h1 = tr_read<IMG + v_rd_off(DD, KS0 + 1, 1)>(vb);
  asm volatile("s_waitcnt lgkmcnt(0)" ::: "memory"); SBAR();
#define PK(L, H) (bf16x8){L[0], L[1], L[2], L[3], H[0], H[1], H[2], H[3]}
  od = __builtin_amdgcn_mfma_f32_32x32x16_bf16(paA, PK(l0, h0), od, 0, 0, 0);
  od = __builtin_amdgcn_mfma_f32_32x32x16_bf16(paB, PK(l1, h1), od, 0, 0, 0);
#undef PK
}
template <int D0> __device__ __forceinline__ void pv_one2(f32x16& od, int vb, bf16x8 pa0, bf16x8 pa1, bf16x8 pa2, bf16x8 pa3) {
  constexpr int IMG = (D0 >> 2) * 16384, DD = D0 & 3;
  const s16x4 l0 = tr_read<IMG + v_rd_off(DD, 0, 0)>(vb), h0 = tr_read<IMG + v_rd_off(DD, 0, 1)>(vb), l1 = tr_read<IMG + v_rd_off(DD, 1, 0)>(vb), h1 = tr_read<IMG + v_rd_off(DD, 1, 1)>(vb);
  const s16x4 l2 = tr_read<IMG + v_rd_off(DD, 2, 0)>(vb), h2 = tr_read<IMG + v_rd_off(DD, 2, 1)>(vb), l3 = tr_read<IMG + v_rd_off(DD, 3, 0)>(vb), h3 = tr_read<IMG + v_rd_off(DD, 3, 1)>(vb);
  asm volatile("s_waitcnt lgkmcnt(0)" ::: "memory"); SBAR();
#define PK(L, H) (bf16x8){L[0], L[1], L[2], L[3], H[0], H[1], H[2], H[3]}
  od = __builtin_amdgcn_mfma_f32_32x32x16_bf16(pa0, PK(l0, h0), od, 0, 0, 0);
  od = __builtin_amdgcn_mfma_f32_32x32x16_bf16(pa1, PK(l1, h1), od, 0, 0, 0);
  od = __builtin_amdgcn_mfma_f32_32x32x16_bf16(pa2, PK(l2, h2), od, 0, 0, 0);
  od = __builtin_amdgcn_mfma_f32_32x32x16_bf16(pa3, PK(l3, h3), od, 0, 0, 0);
#undef PK
}
template <int I> __device__ __forceinline__ void pv_rd(int vb, s16x4& l, s16x4& h) {
  constexpr int D0 = I >> 2, KS = I & 3, IMG = (D0 >> 2) * 16384, DD = D0 & 3;
  l = tr_read<IMG + v_rd_off(DD, KS, 0)>(vb); h = tr_read<IMG + v_rd_off(DD, KS, 1)>(vb);
}
template <int I> __device__ __forceinline__ void pv_step(f32x16* o, int vb, const bf16x8 (&pa)[4], s16x4 (&l)[3], s16x4 (&h)[3]) {
  if constexpr (I + 2 < 32) pv_rd<(I + 2 < 32 ? I + 2 : 0)>(vb, l[(I + 2) % 3], h[(I + 2) % 3]);
  if constexpr (I + 2 < 32) asm volatile("s_waitcnt lgkmcnt(4)" ::: "memory"); else if constexpr (I + 1 < 32) asm volatile("s_waitcnt lgkmcnt(2)" ::: "memory"); else asm volatile("s_waitcnt lgkmcnt(0)" ::: "memory");
  SBAR();
  const s16x4 L = l[I % 3], H = h[I % 3];
  o[I >> 2] = __builtin_amdgcn_mfma_f32_32x32x16_bf16(pa[I & 3], (bf16x8){L[0], L[1], L[2], L[3], H[0], H[1], H[2], H[3]}, o[I >> 2], 0, 0, 0);
  SBAR();
  if constexpr (I + 1 < 32) pv_step<(I + 1 < 32 ? I + 1 : 31)>(o, vb, pa, l, h);
}
__device__ __forceinline__ void pv_all_rolling(f32x16* o, int vb, bf16x8 pa0, bf16x8 pa1, bf16x8 pa2, bf16x8 pa3) {
  const bf16x8 pa[4] = {pa0, pa1, pa2, pa3}; s16x4 l[3], h[3];
  asm volatile("s_waitcnt lgkmcnt(0)" ::: "memory");
  pv_rd<0>(vb, l[0], h[0]); pv_rd<1>(vb, l[1], h[1]);
  pv_step<0>(o, vb, pa, l, h);
}
template <int OFF> __device__ __forceinline__ bf16x8 k_read(int a) { bf16x8 r; asm volatile("ds_read_b128 %0, %1 offset:%2" : "=&v"(r) : "v"(a), "i"(OFF) : "memory"); return r; }
template <int BUFOFF, int D0> __device__ __forceinline__ void qk_step(f32x16& p0, f32x16& p1, int ka0, const bf16x8 (&qr)[8], bf16x8 (&k0)[2], bf16x8 (&k1)[2]) {
  if constexpr (D0 + 1 < 8) { const int a_ = ka0 ^ ((D0 + 1) << 5); k0[(D0 + 1) & 1] = k_read<BUFOFF>(a_); k1[(D0 + 1) & 1] = k_read<BUFOFF + 8192>(a_); }
  if constexpr (D0 + 1 < 8) asm volatile("s_waitcnt lgkmcnt(2)" ::: "memory"); else asm volatile("s_waitcnt lgkmcnt(0)" ::: "memory");
  SBAR();
  p0 = __builtin_amdgcn_mfma_f32_32x32x16_bf16(k0[D0 & 1], qr[D0], p0, 0, 0, 0);
  p1 = __builtin_amdgcn_mfma_f32_32x32x16_bf16(k1[D0 & 1], qr[D0], p1, 0, 0, 0);
  SBAR();
  if constexpr (D0 + 1 < 8) qk_step<BUFOFF, (D0 + 1 < 8 ? D0 + 1 : 7)>(p0, p1, ka0, qr, k0, k1);
}
template <int BUFOFF> __device__ __forceinline__ void qkt_rolling(f32x16& p0, f32x16& p1, int ka0, const bf16x8 (&qr)[8]) {
  bf16x8 k0[2], k1[2];
  asm volatile("s_waitcnt lgkmcnt(0)" ::: "memory");
  k0[0] = k_read<BUFOFF>(ka0); k1[0] = k_read<BUFOFF + 8192>(ka0);
  qk_step<BUFOFF, 0>(p0, p1, ka0, qr, k0, k1);
}
__device__ __forceinline__ void qkt_half(f32x16& p, const char* Ks, const bf16x8* qr, int row, int hi) {
#pragma unroll
  for (int d0 = 0; d0 < 8; ++d0) { const int cb = (d0 * 16 + hi * 8) * 2;
    const bf16x8 b = *reinterpret_cast<const bf16x8*>(Ks + KSWZ(row, cb));
    p = __builtin_amdgcn_mfma_f32_32x32x16_bf16(b, qr[d0], p, 0, 0, 0); }
}
__device__ __forceinline__ void unit_body_da(const Unit& U, char* lds) {
  int tid = threadIdx.x; asm volatile("" : "+v"(tid)); const int wid = __builtin_amdgcn_readfirstlane(tid >> 6), lane = tid & 63, r32 = lane & 31, hi = lane >> 5;
  char* V_lds = lds; char* K_lds = lds + 2 * DA_VB;
  float* ws = (float*)(lds + DA_WS_OFF) + wid * 64; float* li_l = ws; float* al_l = ws + 32;
  float m_reg = -1e30f, l_reg = 0; f32x16 o[8] = {}; bf16x8 qr[8];
  const bf16_t* Qw = U.Q + (long)(wid * QBLK + r32) * LDP + hi * 8;
#pragma unroll
  for (int d0 = 0; d0 < 8; ++d0) qr[d0] = ld8(Qw + d0 * 16);
  const int vb0 = (int)(uintptr_t)V_lds + v_rd_base(lane);
  const int ka0 = (int)(uintptr_t)K_lds + KSWZ(r32, hi * 16);
  constexpr float C = SCALE * 1.4426950408889634f;
  unsigned koff[2], voff[2][2];
#pragma unroll
  for (int i = 0; i < 2; ++i) { const int ob = (2 * wid + i) * 1024 + lane * 16;
    { const int row = ob >> 8, cpos = (ob >> 4) & 15, c = cpos ^ (row & 7); koff[i] = (unsigned)(row * LDP + c * 8); }
    { const int st = ob >> 9, kk = (st >> 2) * 8 + ((ob >> 6) & 7), c = (st & 3) * 32 + ((ob >> 1) & 31), k = (kk & ~0xC) | ((kk & 4) << 1) | ((kk & 8) >> 1);
      voff[0][i] = (unsigned)(k * LDP + c); voff[1][i] = (unsigned)(k * LDP + 128 + c); } }
  typedef __attribute__((address_space(3))) unsigned lds_u32;
#define DDMA(j_, b) do { const bf16_t* kb_ = U.K + (long)(j_) * KVBLK * LDP; const bf16_t* vb__ = U.V + (long)(j_) * KVBLK * LDP; \
    _Pragma("unroll") for (int i = 0; i < 2; ++i) { \
      __builtin_amdgcn_global_load_lds((const unsigned*)(kb_ + koff[i]), (lds_u32*)(K_lds + (b) * DA_KB + (2 * wid + i) * 1024), 16, 0, 0); \
      __builtin_amdgcn_global_load_lds((const unsigned*)(vb__ + voff[0][i]), (lds_u32*)(V_lds + (b) * DA_VB + (2 * wid + i) * 1024), 16, 0, 0); \
      __builtin_amdgcn_global_load_lds((const unsigned*)(vb__ + voff[1][i]), (lds_u32*)(V_lds + (b) * DA_VB + 16384 + (2 * wid + i) * 1024), 16, 0, 0); } } while (0)
#define DPUB() do { asm volatile("s_waitcnt vmcnt(0)" ::: "memory"); __syncthreads(); } while (0)
#define DHALF(b, ROW0, paA, paB) do { f32x16 p = f32x16{}; qkt_half(p, K_lds + (b) * DA_KB, qr, (ROW0) + r32, hi); \
    float pmax = p[0]; _Pragma("unroll") for (int r = 1; r < 16; ++r) pmax = fmaxf(pmax, p[r]); \
    { auto rr = __builtin_amdgcn_permlane32_swap(__float_as_uint(pmax), __float_as_uint(pmax), false, false); pmax = fmaxf(__uint_as_float(rr[0]), __uint_as_float(rr[1])); } \
    float mn, al; if (__builtin_expect(__all(pmax - m_reg <= THR / SCALE), 1)) { mn = m_reg; al = 1.f; } else { mn = fmaxf(m_reg, pmax); al = __builtin_amdgcn_exp2f((m_reg - mn) * C); m_reg = mn; } \
    if (__any(al < 1.f)) { if (hi == 0) al_l[r32] = al; asm volatile("s_waitcnt lgkmcnt(0)" ::: "memory"); \
      _Pragma("unroll") for (int r = 0; r < 16; ++r) { const float f_ = al_l[crow(r, hi)]; _Pragma("unroll") for (int d = 0; d < 8; ++d) o[d][r] *= f_; } } \
    const float mnC = -mn * C; float ps = 0.f; \
    _Pragma("unroll") for (int r = 0; r < 16; ++r) { p[r] = __builtin_amdgcn_exp2f(fmaf(p[r], C, mnC)); ps += p[r]; } \
    { auto rr = __builtin_amdgcn_permlane32_swap(__float_as_uint(ps), __float_as_uint(ps), false, false); ps = __uint_as_float(rr[0]) + __uint_as_float(rr[1]); } \
    l_reg = l_reg * al + ps; \
    { unsigned a0 = cvtpk(p[0], p[1]), a1 = cvtpk(p[2], p[3]), b0 = cvtpk(p[4], p[5]), b1 = cvtpk(p[6], p[7]); \
      auto r0 = __builtin_amdgcn_permlane32_swap(a0, b0, false, false); auto r1 = __builtin_amdgcn_permlane32_swap(a1, b1, false, false); u32x4 w = {r0[0], r1[0], r0[1], r1[1]}; paA = *reinterpret_cast<bf16x8*>(&w); } \
    { unsigned a0 = cvtpk(p[8], p[9]), a1 = cvtpk(p[10], p[11]), b0 = cvtpk(p[12], p[13]), b1 = cvtpk(p[14], p[15]); \
      auto r0 = __builtin_amdgcn_permlane32_swap(a0, b0, false, false); auto r1 = __builtin_amdgcn_permlane32_swap(a1, b1, false, false); u32x4 w = {r0[0], r1[0], r0[1], r1[1]}; paB = *reinterpret_cast<bf16x8*>(&w); } } while (0)
#define DPV(b, KS0, paA, paB) do { const int vb_ = vb0 + (b) * DA_VB; \
    pv_half<0, KS0>(o[0], vb_, paA, paB); pv_half<1, KS0>(o[1], vb_, paA, paB); pv_half<2, KS0>(o[2], vb_, paA, paB); pv_half<3, KS0>(o[3], vb_, paA, paB); \
    pv_half<4, KS0>(o[4], vb_, paA, paB); pv_half<5, KS0>(o[5], vb_, paA, paB); pv_half<6, KS0>(o[6], vb_, paA, paB); pv_half<7, KS0>(o[7], vb_, paA, paB); } while (0)
#define DRESC(a) do { if (__any((a) < 1.f)) { if (hi == 0) al_l[r32] = (a); asm volatile("s_waitcnt lgkmcnt(0)" ::: "memory"); \
    _Pragma("unroll") for (int r = 0; r < 16; ++r) { const float f_ = al_l[crow(r, hi)]; _Pragma("unroll") for (int d = 0; d < 8; ++d) o[d][r] *= f_; } } } while (0)
#define DTILE(b) do { f32x16 p0 = f32x16{}, p1 = f32x16{}; float mn, al; bf16x8 pa0, pa1, pa2, pa3; \
    qkt_rolling<(b) * DA_KB>(p0, p1, ka0, qr); partialSM(p0, p1, m_reg, mn, al); DRESC(al); finishSM(p0, p1, al, l_reg, pa0, pa1, pa2, pa3); SBAR(); \
    pv_all_rolling(o, vb0 + (b) * DA_VB, pa0, pa1, pa2, pa3); } while (0)
  const int NT = U.nt;
  DDMA(0, 0); DPUB();
  for (int j = 0; j < NT; j += 2) {
    DDMA(j + 1, 1); SBAR();
    DTILE(0); SBAR(); DPUB();
    if (j + 2 < NT) DDMA(j + 2, 0); SBAR();
    DTILE(1); SBAR(); DPUB();
  }
  if (hi == 0) li_l[r32] = l_reg; asm volatile("s_waitcnt lgkmcnt(0)" ::: "memory");
  bf16_t* Ow = U.Ob + (long)(wid * QBLK) * LDO;
#pragma unroll
  for (int r = 0; r < 16; ++r) { const int orow = crow(r, hi); const float rl = __builtin_amdgcn_rcpf(li_l[orow]);
#pragma unroll
    for (int d0 = 0; d0 < 8; ++d0) Ow[(long)orow * LDO + d0 * 32 + r32] = (bf16_t)(cvtpk(o[d0][r] * rl, 0.f) & 0xffffu); }
  __syncthreads();
#undef DDMA
#undef DPUB
#undef DHALF
#undef DPV
#undef DTILE
#undef DRESC
}

template <int I> __device__ __forceinline__ void pv4_step(f32x16* o, int vb, const bf16x8 (&pa)[4], s16x4 (&l)[3], s16x4 (&h)[3]) {
  if constexpr (I + 2 < 16) pv_rd<(I + 2 < 16 ? I + 2 : 0)>(vb, l[(I + 2) % 3], h[(I + 2) % 3]);
  if constexpr (I + 2 < 16) asm volatile("s_waitcnt lgkmcnt(4)" ::: "memory"); else if constexpr (I + 1 < 16) asm volatile("s_waitcnt lgkmcnt(2)" ::: "memory"); else asm volatile("s_waitcnt lgkmcnt(0)" ::: "memory");
  SBAR();
  const s16x4 L = l[I % 3], H = h[I % 3];
  o[I >> 2] = __builtin_amdgcn_mfma_f32_32x32x16_bf16(pa[I & 3], (bf16x8){L[0], L[1], L[2], L[3], H[0], H[1], H[2], H[3]}, o[I >> 2], 0, 0, 0);
  SBAR();
  if constexpr (I + 1 < 16) pv4_step<(I + 1 < 16 ? I + 1 : 15)>(o, vb, pa, l, h);
}
template <bool NA> __device__ __forceinline__ void unit_body_v128(const Unit& U, char* lds) {
  int tid = threadIdx.x; asm volatile("" : "+v"(tid)); const int wid = __builtin_amdgcn_readfirstlane(tid >> 6), lane = tid & 63, r32 = lane & 31, hi = lane >> 5;
  char* V_lds = lds; char* K_lds = lds + 2 * DA_VB;
  float* ws = (float*)(lds + DA_WS_OFF) + wid * 64; float* li_l = ws; float* al_l = ws + 32;
  float m_reg = -1e30f, l_reg = 0; f32x16 o[4] = {}; bf16x8 qr[8];
  const bf16_t* Qw = U.Q + (long)(wid * QBLK + r32) * LDP + hi * 8;
#pragma unroll
  for (int d0 = 0; d0 < 8; ++d0) qr[d0] = ld8(Qw + d0 * 16);
  const int vb0 = (int)(uintptr_t)V_lds + v_rd_base(lane);
  const int ka0 = (int)(uintptr_t)K_lds + KSWZ(r32, hi * 16);
  unsigned koff[2], voff[2];
#pragma unroll
  for (int i = 0; i < 2; ++i) { const int ob = (2 * wid + i) * 1024 + lane * 16;
    { const int row = ob >> 8, cpos = (ob >> 4) & 15, c = cpos ^ (row & 7); koff[i] = (unsigned)(row * LDP + c * 8); }
    { const int st = ob >> 9, kk = (st >> 2) * 8 + ((ob >> 6) & 7), c = (st & 3) * 32 + ((ob >> 1) & 31), k = (kk & ~0xC) | ((kk & 4) << 1) | ((kk & 8) >> 1); voff[i] = (unsigned)(k * LDP + c); } }
  typedef __attribute__((address_space(3))) unsigned lds_u32;
  const int nsplit = U.nsplit, base1 = U.base1;
#define NROW(j_) ((long)((j_) < nsplit ? (j_) * KVBLK : base1 + ((j_) - nsplit) * KVBLK))
#define NDMA(j_, b) do { const long rb_ = NROW(j_); const bf16_t* kb_ = U.K + rb_ * LDP; const bf16_t* vb__ = U.V + rb_ * LDP; \
    _Pragma("unroll") for (int i = 0; i < 2; ++i) { \
      __builtin_amdgcn_global_load_lds((const unsigned*)(kb_ + koff[i]), (lds_u32*)(K_lds + (b) * DA_KB + (2 * wid + i) * 1024), 16, 0, 0); \
      __builtin_amdgcn_global_load_lds((const unsigned*)(vb__ + voff[i]), (lds_u32*)(V_lds + (b) * DA_VB + (2 * wid + i) * 1024), 16, 0, 0); } } while (0)
#define NPUB() do { asm volatile("s_waitcnt vmcnt(0)" ::: "memory"); __syncthreads(); } while (0)
#define NRESC(a) do { if (__any((a) < 1.f)) { if (hi == 0) al_l[r32] = (a); asm volatile("s_waitcnt lgkmcnt(0)" ::: "memory"); \
    _Pragma("unroll") for (int r = 0; r < 16; ++r) { const float f_ = al_l[crow(r, hi)]; _Pragma("unroll") for (int d = 0; d < 4; ++d) o[d][r] *= f_; } } } while (0)
#define NTILE(b) do { float mn, al; bf16x8 pa0, pa1, pa2, pa3; \
    qkt_rolling<(b) * DA_KB>(p0, p1, ka0, qr); partialSM(p0, p1, m_reg, mn, al); NRESC(al); finishSM(p0, p1, al, l_reg, pa0, pa1, pa2, pa3); SBAR(); \
    { const bf16x8 pa[4] = {pa0, pa1, pa2, pa3}; s16x4 l[3], h[3]; const int vb_ = vb0 + (b) * DA_VB; asm volatile("s_waitcnt lgkmcnt(0)" ::: "memory"); \
      pv_rd<0>(vb_, l[0], h[0]); pv_rd<1>(vb_, l[1], h[1]); pv4_step<0>(o, vb_, pa, l, h); } } while (0)
  const int NT = U.nt;
  NDMA(0, 0); NPUB();
  for (int j = 0; j < NT; j += 2) {
    f32x16 p0, p1;
    acc_init<NA>(p0, p1, j, U, wid, r32, hi); SBAR();
    NDMA(j + 1, 1); SBAR();
    NTILE(0); SBAR(); NPUB();
    acc_init<NA>(p0, p1, j + 1, U, wid, r32, hi); SBAR();
    if (j + 2 < NT) NDMA(j + 2, 0); SBAR();
    NTILE(1); SBAR(); NPUB();
  }
  if (hi == 0) li_l[r32] = l_reg; asm volatile("s_waitcnt lgkmcnt(0)" ::: "memory");
  if (U.Of) {
    float* Ow = U.Of + (long)(wid * QBLK) * LDO;
#pragma unroll
    for (int r = 0; r < 16; ++r) { const int orow = crow(r, hi); const float rl = __builtin_amdgcn_rcpf(li_l[orow]);
#pragma unroll
      for (int d0 = 0; d0 < 4; ++d0) Ow[(long)orow * LDO + d0 * 32 + r32] = o[d0][r] * rl; }
  } else {
    bf16_t* Ow = U.Ob + (long)(wid * QBLK) * LDO;
#pragma unroll
    for (int r = 0; r < 16; ++r) { const int orow = crow(r, hi); const float rl = __builtin_amdgcn_rcpf(li_l[orow]);
#pragma unroll
      for (int d0 = 0; d0 < 4; ++d0) Ow[(long)orow * LDO + d0 * 32 + r32] = (bf16_t)(cvtpk(o[d0][r] * rl, 0.f) & 0xffffu); }
  }
  __syncthreads();
#undef NROW
#undef NDMA
#undef NPUB
#undef NRESC
#undef NTILE
}
}
#define GAS __attribute__((address_space(1)))
#define LAS __attribute__((address_space(3)))
typedef unsigned short bf16;
typedef unsigned v4u __attribute__((ext_vector_type(4)));
typedef unsigned v2u __attribute__((ext_vector_type(2)));
typedef float f32x4 __attribute__((ext_vector_type(4)));

constexpr int DM = 2048, SEQL = 16384, LC = 256, MT = SEQL + LC;
constexpr int IN_DIM = 6144, DFF = 5632, NUP = 2 * DFF, NMOD = 6 * DM;
constexpr int NLAYER = 2;
constexpr float LN_EPS = 1e-5f;
constexpr float ALPHA = 1.41421356237309515f;

constexpr size_t MiB = 1u << 20;
constexpr size_t WS_MOD = 0;
constexpr size_t WS_BAR = 512 * 1024;
constexpr size_t WS_TICKET = WS_BAR + 16384;
constexpr size_t WS_LAMV = WS_BAR + 32768;
constexpr size_t WS_ROPE = 1 * MiB;
constexpr size_t WS_XC = 2 * MiB;
constexpr size_t WS_PART = 4 * MiB;
constexpr size_t WS_W = 18 * MiB;
constexpr size_t W_IN = 0, W_O = 24 * MiB, W_UP = 32 * MiB, W_DN = 76 * MiB, W_LAYER = 98 * MiB;
constexpr size_t WS_R1 = WS_W + 2 * W_LAYER;
constexpr size_t R1_T = 195 * MiB;
constexpr size_t WS_R2 = WS_R1 + 358 * MiB;
constexpr size_t R2_B = 65 * MiB;
constexpr size_t WS_SLAB_O = WS_R1 + 325 * MiB, WS_SLAB_D = WS_R1 + 65 * MiB;
constexpr int KSPLIT_O = 8, KSPLIT_D = 11;
constexpr size_t WS_NATAB = WS_R2 + 179 * MiB;
constexpr int NATAB_N = 17 * 4096;
constexpr size_t WS_END = WS_NATAB + 5 * MiB;
static_assert((size_t)MT * IN_DIM * 2 <= R1_T && R1_T + (size_t)MT * DM * 4 <= 358 * MiB && (size_t)MT * NUP * 2 <= 358 * MiB && (size_t)MT * DFF * 2 <= 179 * MiB && (size_t)MT * DM * 2 <= R2_B, "ws map");

struct Params { const float* in[19]; float* out; unsigned char* ws; };
enum { I_X = 0, I_C, I_CTX, I_CCTX, I_WADA, I_BADA, I_WIN, I_LAM, I_SUBLN, I_RPB, I_WO, I_LN1G, I_LN1B, I_WUP, I_CONVW, I_CONVB, I_WDN, I_LN2G, I_LN2B };

__device__ __forceinline__ unsigned f2bf(float f) { unsigned u = __builtin_bit_cast(unsigned, f); return (u + 0x7fffu + ((u >> 16) & 1u)) >> 16; }
__device__ __forceinline__ unsigned pk2(float lo, float hi) { return f2bf(lo) | (f2bf(hi) << 16); }
__device__ __forceinline__ float bflo(unsigned w) { return __uint_as_float(w << 16); }
__device__ __forceinline__ float bfhi(unsigned w) { return __uint_as_float(w & 0xffff0000u); }
__device__ __forceinline__ float wave_sum(float v, int lane) {
#pragma unroll
    for (int o = 1; o < 64; o <<= 1) v += __builtin_bit_cast(float, __builtin_amdgcn_ds_bpermute((lane ^ o) << 2, __builtin_bit_cast(int, v)));
    return v;
}
__device__ __forceinline__ float* xrow(const Params& P, int r) { return r < LC ? (float*)(P.ws + WS_XC) + (size_t)r * DM : P.out + (size_t)(r - LC) * DM; }

__device__ __forceinline__ int rope_perm_col(int n) { const int w = n & 127, p = w >> 6, partner = (w >> 5) & 1, i = w & 31, sub = i >> 2, jj = i & 3;
    return (n & ~127) + (p * 2 + (sub >> 2)) * 32 + (sub & 3) * 8 + partner * 4 + jj; }
template <bool ROPEP> __device__ __forceinline__ void transpose_item(const float* W, int K, int N, bf16* WT, LAS float* scr, int item, int lane) {
    const int nblk = N / 32, kb = item / nblk, nb = item % nblk, k0 = 64 * kb, n0 = 32 * nb;
#pragma unroll 8
    for (int i = 0; i < 32; ++i) { const int kk = 2 * i + (lane >> 5); scr[kk * 33 + (lane & 31)] = W[(size_t)(k0 + kk) * N + n0 + (lane & 31)]; }
    asm volatile("s_waitcnt lgkmcnt(0)" ::: "memory");
    const int c = lane & 7;
#pragma unroll
    for (int j = 0; j < 4; ++j) { const int n = (lane >> 3) + 8 * j; const LAS float* s = scr + (8 * c) * 33 + n;
        v4u o; o.x = pk2(s[0 * 33], s[1 * 33]); o.y = pk2(s[2 * 33], s[3 * 33]); o.z = pk2(s[4 * 33], s[5 * 33]); o.w = pk2(s[6 * 33], s[7 * 33]);
        const int nr = (ROPEP && (n0 + n) < 2048) ? rope_perm_col(n0 + n) : (n0 + n);
        *(GAS v4u*)(WT + (size_t)nr * K + k0 + 8 * c) = o; }
    asm volatile("s_waitcnt lgkmcnt(0)" ::: "memory");
}

__device__ __forceinline__ void ph_prologue(const Params& P, unsigned char* lds, int tid, int lane, int wave, int G) {
    float* sl = (float*)lds;
    for (int i = tid; i < 2 * DM; i += 512) { const float v = i < DM ? P.in[I_C][i] : P.in[I_CCTX][i - DM]; sl[i] = v / (1.0f + __expf(-v)); }
    __syncthreads();
    float* part = (float*)(P.ws + WS_PART);
    for (int u = blockIdx.x; u < 2 * 64 * 6; u += G) {
        const int l = u / 384, rem = u % 384, kc = rem / 6, jc = rem % 6, k0 = kc * 32, j = jc * 2048 + tid * 4;
        const float* w = P.in[I_WADA] + ((size_t)l * DM + k0) * NMOD + j;
        f32x4 a0 = {0.f, 0.f, 0.f, 0.f}, a1 = {0.f, 0.f, 0.f, 0.f};
#pragma unroll 8
        for (int kk = 0; kk < 32; ++kk) { const f32x4 wv = *(const f32x4*)(w + (size_t)kk * NMOD); a0 += wv * sl[k0 + kk]; a1 += wv * sl[DM + k0 + kk]; }
        *(f32x4*)(part + ((size_t)(l * 64 + kc) * 2 + 0) * NMOD + j) = a0;
        *(f32x4*)(part + ((size_t)(l * 64 + kc) * 2 + 1) * NMOD + j) = a1;
    }
    const int gtid = blockIdx.x * 512 + tid;
    if (gtid < 320 * 32) {
        const int pos = gtid >> 5, i = gtid & 31; const float p = (float)(pos < 256 ? pos : pos - 256);
        const float inv = exp2f(-(float)(2 * i) * (13.287712379549449f / 64.0f)); const float ang = p * inv;
        const double rev = (double)ang * 0.15915494309189535; const float fr_ = (float)(rev - floor(rev));
        float* rt = (float*)(P.ws + WS_ROPE) + (size_t)gtid * 2; rt[0] = __builtin_amdgcn_cosf(fr_); rt[1] = __builtin_amdgcn_sinf(fr_);
    }
    if (blockIdx.x == 0 && wave < NLAYER) {
        const int l = wave; const float* lv = P.in[I_LAM] + (size_t)l * 4 * 128;
        const float s01 = wave_sum(lv[lane] * lv[128 + lane] + lv[64 + lane] * lv[192 + lane], lane);
        const float s23 = wave_sum(lv[256 + lane] * lv[384 + lane] + lv[320 + lane] * lv[448 + lane], lane);
        const float lam_init = 0.8f - 0.6f * expf(-0.3f * (float)l);
        if (lane == 0) { float* o = (float*)(P.ws + WS_LAMV) + 2 * l; o[0] = expf(s01) - expf(s23) + lam_init; o[1] = 1.0f - lam_init; }
    }
    {
        float* nt = (float*)(P.ws + WS_NATAB);
        for (int o = gtid; o < NLAYER * 8 * NATAB_N; o += G * 512) {
            const int lh = o / NATAB_N, rem = o % NATAB_N, slice = rem >> 12, c = (rem >> 6) & 63, kc = rem & 63;
            int cs = c - 8; cs = cs < 0 ? 0 : (cs > 48 ? 48 : cs);
            float v = 0.f;
            if (slice == 15) v = -1e30f;
            else if (slice < 15) v = (kc >= cs && kc < cs + 16) ? P.in[I_RPB][(size_t)lh * att::RPB_N + slice * 31 + (kc - c + 15)] * (1.0f / att::SCALE) : -1e30f;
            nt[o] = v;
        }
    }
    __syncthreads();
    LAS float* scr = (LAS float*)((LAS unsigned char*)lds + wave * 16384);
    const int gw = blockIdx.x * 8 + wave, NGW = G * 8;
    constexpr int I_1 = (DM / 64) * (IN_DIM / 32), I_2 = (DM / 64) * (DM / 32), I_3 = (DM / 64) * (NUP / 32), I_4 = (DFF / 64) * (DM / 32), I_L = I_1 + I_2 + I_3 + I_4;
    for (int it = gw; it < NLAYER * I_L; it += NGW) {
        const int l = it / I_L; int r = it % I_L; unsigned char* wl = P.ws + WS_W + (size_t)l * W_LAYER;
        if (r < I_1) { transpose_item<true>(P.in[I_WIN] + (size_t)l * DM * IN_DIM, DM, IN_DIM, (bf16*)(wl + W_IN), scr, r, lane); continue; } r -= I_1;
        if (r < I_2) { transpose_item<false>(P.in[I_WO] + (size_t)l * DM * DM, DM, DM, (bf16*)(wl + W_O), scr, r, lane); continue; } r -= I_2;
        if (r < I_3) { transpose_item<false>(P.in[I_WUP] + (size_t)l * DM * NUP, DM, NUP, (bf16*)(wl + W_UP), scr, r, lane); continue; } r -= I_3;
        transpose_item<false>(P.in[I_WDN] + (size_t)l * DFF * DM, DFF, DM, (bf16*)(wl + W_DN), scr, r, lane);
    }
}
__device__ __forceinline__ void ph_modreduce(const Params& P, int gtid, int NTH) {
    const float* part = (const float*)(P.ws + WS_PART); float* mod = (float*)(P.ws + WS_MOD);
    for (int o = gtid; o < NLAYER * 2 * NMOD; o += NTH) {
        const int l = o / (2 * NMOD), which = (o / NMOD) & 1, j = o % NMOD;
        float s = P.in[I_BADA][l * NMOD + j];
        for (int kc = 0; kc < 64; ++kc) s += part[((size_t)(l * 64 + kc) * 2 + which) * NMOD + j];
        mod[o] = s;
    }
}
__device__ __forceinline__ const float* modp(const Params& P, int l, int which, int k) { return (const float*)(P.ws + WS_MOD) + (size_t)(l * 2 + which) * NMOD + (size_t)k * DM; }

__device__ __forceinline__ void ph_modulate0(const Params& P, int gw, int NGW, int lane) {
    bf16* H = (bf16*)(P.ws + WS_R2);
    for (int r0 = gw; r0 < MT; r0 += 2 * NGW) {
        f32x4 xv[2][8];
#pragma unroll
        for (int q = 0; q < 2; ++q) { const int r = r0 + q * NGW; if (r < MT) { const float* src = r < LC ? P.in[I_CTX] + (size_t)r * DM : P.in[I_X] + (size_t)(r - LC) * DM;
#pragma unroll
            for (int j = 0; j < 8; ++j) xv[q][j] = *(const f32x4*)(src + 4 * lane + 256 * j); } }
#pragma unroll
        for (int q = 0; q < 2; ++q) { const int r = r0 + q * NGW; if (r < MT) { const int which = r < LC; const float* sh = modp(P, 0, which, 0); const float* sc = modp(P, 0, which, 1);
#pragma unroll
            for (int j = 0; j < 8; ++j) { const int col = 4 * lane + 256 * j; const f32x4 s = *(const f32x4*)(sc + col), t = *(const f32x4*)(sh + col);
                const f32x4 o = xv[q][j] * (s + 1.0f) + t; v2u w; w.x = pk2(o[0], o[1]); w.y = pk2(o[2], o[3]); *(v2u*)(H + (size_t)r * DM + col) = w; } } }
    }
}
__device__ __forceinline__ void ph_rope(const Params& P, int gw, int NGW, int lane) {
    bf16* proj = (bf16*)(P.ws + WS_R1); const float* tab = (const float*)(P.ws + WS_ROPE);
    for (int r0 = LC + gw; r0 < MT; r0 += 2 * NGW) {
        v4u a[2][2], bq[2][2];
#pragma unroll
        for (int q = 0; q < 2; ++q) { const int r = r0 + q * NGW; if (r < MT) { bf16* row = proj + (size_t)r * IN_DIM;
#pragma unroll
            for (int k = 0; k < 2; ++k) { const int unit = lane + 64 * k, b = unit >> 3, p = (unit >> 2) & 1, i0 = (unit & 3) * 8; const bf16* p1 = row + b * 128 + p * 64 + i0;
                a[q][k] = *(const v4u*)p1; bq[q][k] = *(const v4u*)(p1 + 32); } } }
#pragma unroll
        for (int q = 0; q < 2; ++q) { const int r = r0 + q * NGW; if (r < MT) { const int t = r - LC, pr = t >> 6, pc = t & 63; bf16* row = proj + (size_t)r * IN_DIM;
#pragma unroll
            for (int k = 0; k < 2; ++k) {
                const int unit = lane + 64 * k, b = unit >> 3, p = (unit >> 2) & 1, i0 = (unit & 3) * 8; bf16* p1 = row + b * 128 + p * 64 + i0;
                const float* tb = tab + ((size_t)(p ? 256 + pc : pr) * 32 + i0) * 2; v4u oa, ob;
#pragma unroll
                for (int e = 0; e < 4; ++e) {
                    const f32x4 cs = *(const f32x4*)(tb + 4 * e);
                    const float x1l = bflo(a[q][k][e]), x1h = bfhi(a[q][k][e]), x2l = bflo(bq[q][k][e]), x2h = bfhi(bq[q][k][e]);
                    oa[e] = pk2(x1l * cs[0] - x2l * cs[1], x1h * cs[2] - x2h * cs[3]);
                    ob[e] = pk2(x2l * cs[0] + x1l * cs[1], x2h * cs[2] + x1h * cs[3]);
                }
                *(v4u*)p1 = oa; *(v4u*)(p1 + 32) = ob;
            } } }
    }
}
__device__ __forceinline__ void ph_combine(const Params& P, int l, int gw, int NGW, int lane) {
    const float* T = (const float*)(P.ws + WS_R1 + R1_T); bf16* AO = (bf16*)(P.ws + WS_R2 + R2_B);
    const float lam = ((const float*)(P.ws + WS_LAMV))[2 * l], osc = ((const float*)(P.ws + WS_LAMV))[2 * l + 1];
    const f32x4 g = *(const f32x4*)(P.in[I_SUBLN] + (size_t)l * 256 + 4 * lane);
    const int r_lo = (l == NLAYER - 1) ? LC : 0;
    for (int r = r_lo + gw; r < MT; r += NGW) {
        f32x4 o1[4], o2[4];
#pragma unroll
        for (int h = 0; h < 4; ++h) { const v2u a_ = *(const v2u*)((const bf16*)T + (size_t)r * DM + h * 512 + 4 * lane), b_ = *(const v2u*)((const bf16*)T + (size_t)r * DM + h * 512 + 256 + 4 * lane);
            o1[h] = (f32x4){bflo(a_.x), bfhi(a_.x), bflo(a_.y), bfhi(a_.y)}; o2[h] = (f32x4){bflo(b_.x), bfhi(b_.x), bflo(b_.y), bfhi(b_.y)}; }
#pragma unroll
        for (int h = 0; h < 4; ++h) {
            const f32x4 d = o1[h] - o2[h] * lam;
            const float ss = wave_sum(d[0] * d[0] + d[1] * d[1] + d[2] * d[2] + d[3] * d[3], lane);
            const float rinv = 1.0f / sqrtf(ss * (1.0f / 256.0f) + LN_EPS);
            const f32x4 o = d * rinv * g * osc;
            v2u w; w.x = pk2(o[0], o[1]); w.y = pk2(o[2], o[3]); *(v2u*)(AO + (size_t)r * DM + h * 256 + 4 * lane) = w;
        }
    }
}
__device__ __forceinline__ void ph_ln(const Params& P, int l, int stage, unsigned char* lds, int tid, int gw, int NGW, int lane) {
    const bool last = (l == NLAYER - 1);
    const bf16* ADD = stage == 1 ? (const bf16*)(P.ws + WS_R2) : (const bf16*)(P.ws + WS_R1);
    bf16* HN = stage == 1 ? (bf16*)(P.ws + WS_R2 + R2_B) : (bf16*)(P.ws + WS_R2);
    const float* lg = (stage == 1 ? P.in[I_LN1G] : P.in[I_LN2G]) + (size_t)l * DM; const float* lb = (stage == 1 ? P.in[I_LN1B] : P.in[I_LN2B]) + (size_t)l * DM;
    const float* SLAB = (const float*)(P.ws + (stage == 1 ? WS_SLAB_O : WS_SLAB_D));
    const bool write_h = (stage == 1) || !last;
    const int r_lo = last ? LC : 0, lsc = stage == 1 ? l : (last ? l : l + 1);
    float* V = (float*)lds;
    for (int i = tid; i < 8 * DM; i += 512) {
        const int k = i / DM, c = i % DM; float v;
        if (k == 3) v = lg[c]; else if (k == 4) v = lb[c];
        else { const int which = k >= 5, kk = which ? k - 5 : k;
            v = kk == 0 ? modp(P, l, which, stage == 1 ? 2 : 5)[c] : (kk == 1 ? modp(P, lsc, which, stage == 1 ? 4 : 1)[c] : modp(P, lsc, which, stage == 1 ? 3 : 0)[c]); }
        V[i] = v;
    }
    __syncthreads();
    f32x4 xa[8]; v2u ya[8];
#define LN_LOAD(rr, X, Y) do { const float* xin_ = (stage == 1 && l == 0) ? ((rr) < LC ? P.in[I_CTX] + (size_t)(rr) * DM : P.in[I_X] + (size_t)((rr) - LC) * DM) : xrow(P, (rr)); const bf16* ad_ = ADD + (size_t)(rr) * DM; \
        _Pragma("unroll") for (int j = 0; j < 8; ++j) { const int col_ = 4 * lane + 256 * j; X[j] = *(const f32x4*)(xin_ + col_); \
            if (l == 0 && (rr) < LC) { const float* sp_ = SLAB + (size_t)(rr) * DM + col_; f32x4 a_ = *(const f32x4*)sp_; _Pragma("unroll") for (int s_ = 1; s_ < KSPLIT_D; ++s_) if (s_ < (stage == 1 ? KSPLIT_O : KSPLIT_D)) a_ += *(const f32x4*)(sp_ + (size_t)s_ * 256 * DM); \
                v2u w_; w_.x = pk2(a_[0], a_[1]); w_.y = pk2(a_[2], a_[3]); Y[j] = w_; } else Y[j] = *(const v2u*)(ad_ + col_); } } while (0)
    int r = r_lo + gw;
    if (r < MT) LN_LOAD(r, xa, ya);
    while (r < MT) {
        const int rn = r + NGW; f32x4 xb[8]; v2u yb[8];
#pragma unroll
        for (int j = 0; j < 8; ++j) { xb[j] = (f32x4){0.f, 0.f, 0.f, 0.f}; yb[j] = (v2u){0u, 0u}; }
        if (rn < MT) LN_LOAD(rn, xb, yb);
        const int which = r < LC; const float* gt = V + (which ? 5 : 0) * DM; const float* scv = V + (which ? 6 : 1) * DM; const float* shv = V + (which ? 7 : 2) * DM;
        float* xo = xrow(P, r);
        f32x4 v[8]; float s = 0.f;
#pragma unroll
        for (int j = 0; j < 8; ++j) { const int col = 4 * lane + 256 * j; const f32x4 g4 = *(const f32x4*)(gt + col);
            const f32x4 a = {bflo(ya[j].x), bfhi(ya[j].x), bflo(ya[j].y), bfhi(ya[j].y)};
            v[j] = xa[j] * ALPHA + g4 * a; s += (v[j][0] + v[j][1]) + (v[j][2] + v[j][3]); }
        const float mean = wave_sum(s, lane) * (1.0f / DM); float s2 = 0.f;
#pragma unroll
        for (int j = 0; j < 8; ++j) { v[j] = v[j] - mean; s2 += (v[j][0] * v[j][0] + v[j][1] * v[j][1]) + (v[j][2] * v[j][2] + v[j][3] * v[j][3]); }
        const float rstd = 1.0f / sqrtf(wave_sum(s2, lane) * (1.0f / DM) + LN_EPS);
#pragma unroll
        for (int j = 0; j < 8; ++j) { const int col = 4 * lane + 256 * j; const f32x4 gg = *(const f32x4*)(V + 3 * DM + col), bb = *(const f32x4*)(V + 4 * DM + col);
            const f32x4 o = v[j] * rstd * gg + bb; *(f32x4*)(xo + col) = o;
            if (write_h) { const f32x4 s4 = *(const f32x4*)(scv + col), t4 = *(const f32x4*)(shv + col); const f32x4 hv = o * (s4 + 1.0f) + t4;
                v2u w; w.x = pk2(hv[0], hv[1]); w.y = pk2(hv[2], hv[3]); *(v2u*)(HN + (size_t)r * DM + col) = w; } }
#pragma unroll
        for (int j = 0; j < 8; ++j) { xa[j] = xb[j]; ya[j] = yb[j]; }
        r = rn;
    }
#undef LN_LOAD
    __syncthreads();
}
__device__ __forceinline__ void ph_conv(const Params& P, int l, int gtid, int NTH) {
    const bf16* UP = (const bf16*)(P.ws + WS_R1); bf16* ACT = (bf16*)(P.ws + WS_R2);
    const float* cw = P.in[I_CONVW] + (size_t)l * 3 * DFF; const float* cb = P.in[I_CONVB] + (size_t)l * DFF;
    constexpr int NCG = DFF / 8, RS = 8, NSTRIP = MT / RS;
    const int s_lo = (l == NLAYER - 1) ? LC / RS : 0;
    for (int it = s_lo * NCG + gtid; it < NSTRIP * NCG; it += NTH) {
        const int cgi = it % NCG, strip = it / NCG, ch = cgi * 8, r0 = strip * RS;
        const bool hasprev = (r0 != 0) && (r0 != LC), hasnext = (r0 + RS != LC) && (r0 + RS != MT);
        v4u g[RS + 2], u[RS];
        g[0] = (v4u){0u, 0u, 0u, 0u}; g[RS + 1] = (v4u){0u, 0u, 0u, 0u};
        if (hasprev) g[0] = *(const v4u*)(UP + (size_t)(r0 - 1) * NUP + ch);
#pragma unroll
        for (int i = 0; i < RS; ++i) { g[i + 1] = *(const v4u*)(UP + (size_t)(r0 + i) * NUP + ch); u[i] = *(const v4u*)(UP + (size_t)(r0 + i) * NUP + DFF + ch); }
        if (hasnext) g[RS + 1] = *(const v4u*)(UP + (size_t)(r0 + RS) * NUP + ch);
        float w0[8], w1[8], w2[8], bb[8];
#pragma unroll
        for (int e = 0; e < 8; ++e) { w0[e] = cw[ch + e]; w1[e] = cw[DFF + ch + e]; w2[e] = cw[2 * DFF + ch + e]; bb[e] = cb[ch + e]; }
#pragma unroll
        for (int i = 0; i < RS; ++i) { v4u o;
#pragma unroll
            for (int e = 0; e < 4; ++e) {
                const float ga = bflo(g[i][e]) * w0[2 * e] + bflo(g[i + 1][e]) * w1[2 * e] + bflo(g[i + 2][e]) * w2[2 * e] + bb[2 * e];
                const float gb = bfhi(g[i][e]) * w0[2 * e + 1] + bfhi(g[i + 1][e]) * w1[2 * e + 1] + bfhi(g[i + 2][e]) * w2[2 * e + 1] + bb[2 * e + 1];
                const float sa = ga / (1.0f + __expf(-ga)), sb = gb / (1.0f + __expf(-gb));
                o[e] = pk2(sa * bflo(u[i][e]), sb * bfhi(u[i][e]));
            }
            *(v4u*)(ACT + (size_t)(r0 + i) * DFF + ch) = o; }
    }
}
__device__ __forceinline__ void ph_attn(const Params& P, int l, unsigned char* lds, int vcu, int G) {
    const bf16* proj = (const bf16*)(P.ws + WS_R1); float* T = (float*)(P.ws + WS_R1 + R1_T); bf16* AO = (bf16*)(P.ws + WS_R2 + R2_B);
    const int n_units = 512 + 512 + (l == 0 ? 16 : 0);
#pragma unroll 1
    for (int u = vcu; u < n_units; u += G) {
        att::Unit U;
        U.Of = nullptr; U.Ob = nullptr; U.natab = nullptr; U.na = 0; U.qrow0 = 0; U.kr0 = 0; U.base1 = 0;
        int kind = 0;
        if (u < 512) {
            const int hc = u >> 6, qb = u & 63, h = hc >> 1, c = hc & 1; const size_t q0 = (size_t)(LC + qb * 256);
            U.Q = proj + q0 * IN_DIM + h * 256 + c * 128; U.K = proj + 1024 + h * 256 + c * 128; U.V = proj + 2048 + h * 256;
            U.Ob = (bf16*)T + q0 * DM + h * 512 + c * 256; U.nt = MT / 64; U.nsplit = MT / 64;
        } else if (u < 1024) {
            const int un = u - 512, h = un >> 6, qb = un & 63; const size_t q0 = (size_t)(LC + qb * 256);
            int start = 4 * qb - 4; start = start < 0 ? 0 : (start > 244 ? 244 : start);
            U.Q = proj + q0 * IN_DIM + 3072 + h * 128; U.K = proj + 4096 + h * 128; U.V = proj + 5120 + h * 128;
            U.Ob = AO + q0 * DM + 1024 + h * 128; U.nt = 16; U.nsplit = 4; U.base1 = LC + start * 64; U.na = 1; U.qrow0 = 4 * qb; U.kr0 = start;
            U.natab = (const float*)(P.ws + WS_NATAB) + (size_t)(l * 8 + h) * NATAB_N; kind = 2;
        } else {
            const int v = u - 1024;
            if (v < 8) { const int h = v >> 1, c = v & 1;
                U.Q = proj + h * 256 + c * 128; U.K = proj + 1024 + h * 256 + c * 128; U.V = proj + 2048 + h * 256; U.Ob = (bf16*)T + h * 512 + c * 256; }
            else { const int h = v - 8; U.Q = proj + 3072 + h * 128; U.K = proj + 4096 + h * 128; U.V = proj + 5120 + h * 128; U.Ob = AO + 1024 + h * 128; kind = 1; }
            U.nt = 4; U.nsplit = 4;
        }
        if (kind == 0) att::unit_body_da(U, (char*)lds); else if (kind == 2) att::unit_body_v128<true>(U, (char*)lds); else att::unit_body_v128<false>(U, (char*)lds);
    }
}

#define XB_TMO      128
#define XB_XCNT(j)  (256  + 64 * (j))
#define XB_XSUB(j)  (1280 + 64 * (j))
#define XB_XGEN(j)  (2304 + 64 * (j))
#define XB_TOP      3328
#define XB_TOPGEN   3392
#define XCD_BAR_WORDS 3456
#define XB_SPIN_CAP (1u << 18)

__device__ __forceinline__ unsigned xb_ld(unsigned* p)              { return __hip_atomic_load(p, __ATOMIC_RELAXED, __HIP_MEMORY_SCOPE_AGENT); }
__device__ __forceinline__ unsigned xb_add(unsigned* p, unsigned v) { return __hip_atomic_fetch_add(p, v, __ATOMIC_RELAXED, __HIP_MEMORY_SCOPE_AGENT); }
__device__ __forceinline__ unsigned xb_xcc_id() { return (unsigned)__builtin_amdgcn_s_getreg((3 << 11) | 20) & 0xFu; }
#define XB_SPIN(cond, bar) do { unsigned _sp = 0; while (cond) { __builtin_amdgcn_s_sleep(1); \
    if ((++_sp & 255u) == 0u) { if (xb_ld(&(bar)[XB_TMO])) break; if (_sp > XB_SPIN_CAP) { atomicAdd(&(bar)[XB_TMO], 1u); break; } } } } while (0)

struct XcdBarrier {
    unsigned* bar; unsigned x;
    volatile LAS unsigned* st;
};

__device__ __forceinline__ XcdBarrier xcd_barrier_post(unsigned* bar, volatile LAS unsigned* st) {
    XcdBarrier b; b.bar = bar; b.x = xb_xcc_id(); b.st = st;
    if (threadIdx.x == 0) (void)xb_add(&bar[XB_XCNT(b.x)], 1u);
    return b;
}
__device__ __forceinline__ void xcd_barrier_complete(unsigned* bar, unsigned x, unsigned& nloc, unsigned& nx) {
    const unsigned G = gridDim.x * gridDim.y * gridDim.z;
    unsigned sum, cnt, mine, sp = 0u;
    for (;;) {
        sum = 0u; cnt = 0u; mine = 0u;
#pragma unroll
        for (unsigned j = 0; j < 16; ++j) { const unsigned c = xb_ld(&bar[XB_XCNT(j)]); sum += c; cnt += (c > 0u) ? 1u : 0u; mine = (j == x) ? c : mine; }
        if (sum == G) break;
        __builtin_amdgcn_s_sleep(1);
        if ((++sp & 255u) == 0u) { if (xb_ld(&bar[XB_TMO])) break; if (sp > XB_SPIN_CAP) { atomicAdd(&bar[XB_TMO], 1u); break; } }
    }
    nloc = mine > 0u ? mine : 1u; nx = cnt > 0u ? cnt : 1u;
}

__device__ __forceinline__ void xcd_barrier(const XcdBarrier& b) {
    asm volatile("s_waitcnt vmcnt(0)" ::: "memory");
    __syncthreads();
    if (threadIdx.x == 0) {
        unsigned* bar = b.bar;
        __builtin_amdgcn_s_waitcnt(0);
        unsigned nloc = b.st[0], nx = b.st[1];
        if (nloc == 0u) { xcd_barrier_complete(bar, b.x, nloc, nx); b.st[0] = nloc; b.st[1] = nx; }
        const unsigned old = xb_add(&bar[XB_XSUB(b.x)], 1u);
        const unsigned gen = old / nloc;
        if (old + 1u == (gen + 1u) * nloc) {
            __builtin_amdgcn_fence(__ATOMIC_RELEASE, "agent");
            asm volatile("s_waitcnt vmcnt(0)" ::: "memory");
            const unsigned og = xb_add(&bar[XB_TOP], 1u);
            const unsigned tg = og / nx;
            if (og + 1u == (tg + 1u) * nx) xb_add(&bar[XB_TOPGEN], 1u);
            else XB_SPIN(xb_ld(&bar[XB_TOPGEN]) == tg, bar);
            __builtin_amdgcn_fence(__ATOMIC_ACQUIRE, "agent");
            xb_add(&bar[XB_XGEN(b.x)], 1u);
            asm volatile("s_waitcnt vmcnt(0)" ::: "memory");
        } else {
            XB_SPIN(xb_ld(&bar[XB_XGEN(b.x)]) == gen, bar);
            __builtin_amdgcn_fence(__ATOMIC_ACQUIRE, "agent");
            asm volatile("s_waitcnt vmcnt(0)" ::: "memory");
        }
    }
    __syncthreads();
}
constexpr int LDS_BYTES = 135168;
static_assert(att::SHM_ATTN <= 131072 && att::SHM_DA <= 131072 && pg8::STAGE_BYTES == 131072, "LDS map");

constexpr int NPHASES = 3 + NLAYER * 9;
__global__ void __launch_bounds__(512) mega_fwd(Params P) {
    extern __shared__ __attribute__((aligned(16))) unsigned char lds[];
    cg::grid_group grid = cg::this_grid();
    { volatile LAS unsigned* st_ = (volatile LAS unsigned*)((LAS unsigned char*)lds + 131072); if (threadIdx.x < 16) st_[threadIdx.x] = 0u; }
    __syncthreads();
    const XcdBarrier xbar = xcd_barrier_post((unsigned*)(P.ws + WS_BAR), (volatile LAS unsigned*)((LAS unsigned char*)lds + 131072));
    const int G = gridDim.x, bx = blockIdx.x;
#define VCU ((G % 8 == 0) ? (bx % 8) * (G / 8) + bx / 8 : bx)
    int ph = 0;
#define NGW (G * 8)
#define NTH (G * 512)
#define RUN(body) do { { int tid = threadIdx.x; asm volatile("" : "+v"(tid)); const int lane = tid & 63, wave = __builtin_amdgcn_readfirstlane(tid >> 6), gw = bx * 8 + wave, gtid = bx * 512 + tid; (void)lane; (void)gw; (void)gtid; body; } if (ph + 1 < NPHASES) { if (G < 0) grid.sync(); else xcd_barrier(xbar); } ++ph; } while (0)
#define GEMM(Aptr, Wptr, Optr, M_, N_, K_) do { pg8::Gemm g{(const pg8::bf16_t*)(Aptr), (const pg8::bf16_t*)(Wptr), (M_), (N_), (K_), (K_)}; pg8::StaticOrder S; S.init((M_), (N_), G, bx); \
        pg8::EpiBf16 E{(pg8::bf16_t*)(Optr), (N_)}; pg8::gemm_phase<pg8::EpiBf16, pg8::StaticOrder, true, true>((PG8_LAS unsigned char*)lds, g, S, E); } while (0)
      \
#define GEMM_CTX(Aptr, Wptr, SLAB, N_, K_, S_) do { const int nun_ = ((N_) / 256) * (S_); const bool has_ = bx < nun_; const int pn_ = has_ ? bx / (S_) : 0, sp_ = has_ ? bx % (S_) : 0; constexpr int Kc_ = (K_) / (S_); \
        pg8::Gemm g{(const pg8::bf16_t*)(Aptr) + sp_ * Kc_, (const pg8::bf16_t*)(Wptr) + sp_ * Kc_, 256, (N_), Kc_, (K_)}; pg8::OneUnit S{pn_, has_}; \
        pg8::EpiF32 E{(float*)(SLAB), (N_), sp_}; pg8::gemm_phase<pg8::EpiF32, pg8::OneUnit, false, true>((PG8_LAS unsigned char*)lds, g, S, E); } while (0)
#define GEMM_PROJ(Aptr, Wptr, Optr) do { pg8::Gemm g{(const pg8::bf16_t*)(Aptr), (const pg8::bf16_t*)(Wptr), MT, IN_DIM, DM, DM}; pg8::StaticOrder S; S.init(MT, IN_DIM, G, bx); \
        pg8::EpiProj E{(pg8::bf16_t*)(Optr), IN_DIM, (const float*)(P.ws + WS_ROPE)}; pg8::gemm_phase<pg8::EpiProj, pg8::StaticOrder, true, true>((PG8_LAS unsigned char*)lds, g, S, E); } while (0)
#ifndef SKIP_PRO
    RUN(ph_prologue(P, lds, tid, lane, wave, G));
#endif
    RUN(ph_modreduce(P, gtid, NTH));
    RUN(ph_modulate0(P, gw, NGW, lane));
    {
        constexpr int l = 0; constexpr bool last = (l == NLAYER - 1);
        constexpr size_t ro = LC;
        const size_t ru = last ? (size_t)LC : 0; const int Mu = last ? SEQL : MT;
#define wl (P.ws + WS_W + (size_t)l * W_LAYER)
        RUN(GEMM_PROJ(P.ws + WS_R2, wl + W_IN, P.ws + WS_R1));
        RUN(ph_attn(P, l, lds, VCU, G));
        RUN(ph_combine(P, l, gw, NGW, lane));
        RUN(GEMM(P.ws + WS_R2 + R2_B + ro * DM * 2, wl + W_O, P.ws + WS_R2 + ro * DM * 2, SEQL, DM, DM); if (!last) GEMM_CTX(P.ws + WS_R2 + R2_B, wl + W_O, P.ws + WS_SLAB_O, DM, DM, KSPLIT_O));
        RUN(ph_ln(P, l, 1, lds, tid, gw, NGW, lane));
        RUN(GEMM(P.ws + WS_R2 + R2_B + ru * DM * 2, wl + W_UP, P.ws + WS_R1 + ru * NUP * 2, Mu, NUP, DM));
        RUN(ph_conv(P, l, gtid, NTH));
        RUN(GEMM(P.ws + WS_R2 + ro * DFF * 2, wl + W_DN, P.ws + WS_R1 + ro * DM * 2, SEQL, DM, DFF); if (!last) GEMM_CTX(P.ws + WS_R2, wl + W_DN, P.ws + WS_SLAB_D, DM, DFF, KSPLIT_D));
        RUN(ph_ln(P, l, 2, lds, tid, gw, NGW, lane));
    }
    {
        constexpr int l = 1; constexpr bool last = (l == NLAYER - 1);
        constexpr size_t ro = LC;
        const size_t ru = last ? (size_t)LC : 0; const int Mu = last ? SEQL : MT;
        RUN(GEMM_PROJ(P.ws + WS_R2, wl + W_IN, P.ws + WS_R1));
        RUN(ph_attn(P, l, lds, VCU, G));
        RUN(ph_combine(P, l, gw, NGW, lane));
        RUN(GEMM(P.ws + WS_R2 + R2_B + ro * DM * 2, wl + W_O, P.ws + WS_R2 + ro * DM * 2, SEQL, DM, DM); if (!last) GEMM_CTX(P.ws + WS_R2 + R2_B, wl + W_O, P.ws + WS_SLAB_O, DM, DM, KSPLIT_O));
        RUN(ph_ln(P, l, 1, lds, tid, gw, NGW, lane));
        RUN(GEMM(P.ws + WS_R2 + R2_B + ru * DM * 2, wl + W_UP, P.ws + WS_R1 + ru * NUP * 2, Mu, NUP, DM));
        RUN(ph_conv(P, l, gtid, NTH));
        RUN(GEMM(P.ws + WS_R2 + ro * DFF * 2, wl + W_DN, P.ws + WS_R1 + ro * DM * 2, SEQL, DM, DFF); if (!last) GEMM_CTX(P.ws + WS_R2, wl + W_DN, P.ws + WS_SLAB_D, DM, DFF, KSPLIT_D));
        RUN(ph_ln(P, l, 2, lds, tid, gw, NGW, lane));
    }
#undef RUN
#undef wl
#undef GEMM
#undef GEMM_PROJ
#undef VCU
#undef NGW
#undef NTH
}

extern "C" void kernel_launch(void* const* d_in, const int* in_sizes, int n_in, void* d_out, int out_size, void* d_ws, size_t ws_size, hipStream_t stream) {
    static int grid = 0;
    if (grid == 0) {
        if (n_in != 19 || in_sizes[0] != SEQL * DM || out_size != SEQL * DM || ws_size < WS_END) { fprintf(stderr, "kernel_launch: shape/workspace mismatch (n_in %d, ws %zu < %zu)\n", n_in, ws_size, (size_t)WS_END); grid = -1; return; }
        int dev = 0, cus = 0, per_cu = 0;
        if (hipGetDevice(&dev) != hipSuccess || hipDeviceGetAttribute(&cus, hipDeviceAttributeMultiprocessorCount, dev) != hipSuccess) { grid = -1; return; }
        if (hipFuncSetAttribute((const void*)mega_fwd, hipFuncAttributeMaxDynamicSharedMemorySize, LDS_BYTES) != hipSuccess) { fprintf(stderr, "kernel_launch: hipFuncSetAttribute failed\n"); grid = -1; return; }
        if (hipOccupancyMaxActiveBlocksPerMultiprocessor(&per_cu, (const void*)mega_fwd, 512, LDS_BYTES) != hipSuccess || per_cu < 1) { fprintf(stderr, "kernel_launch: occupancy query says %d\n", per_cu); per_cu = 1; }
        (void)hipGetLastError();
        grid = cus * 1;
    }
    if (grid < 0) return;
    if (hipMemsetAsync((char*)d_ws + WS_BAR, 0, 16384 + 8 * 64 * 4, stream) != hipSuccess) { fprintf(stderr, "kernel_launch: memset failed\n"); return; }
    Params p{};
    for (int i = 0; i < 19; ++i) p.in[i] = (const float*)d_in[i];
    p.out = (float*)d_out; p.ws = (unsigned char*)d_ws;
    void* args[] = {&p};
    hipError_t e = hipLaunchCooperativeKernel((const void*)mega_fwd, dim3(grid), dim3(512), args, LDS_BYTES, stream);
    if (e != hipSuccess) fprintf(stderr, "kernel_launch: cooperative launch failed: %s (grid %d)\n", hipGetErrorString(e), grid);
}
```

```cpp
#include <hip/hip_runtime.h>
#include <hip/hip_bf16.h>
#include <hip/hip_cooperative_groups.h>
#include <cstdio>
#include <cstdint>
#include <cmath>
namespace cg = cooperative_groups;
namespace pg8 {
#define PG8_LAS __attribute__((address_space(3)))
typedef unsigned short bf16_t;
typedef short bf16x8 __attribute__((ext_vector_type(8)));
typedef float f32x4 __attribute__((ext_vector_type(4)));
typedef unsigned u32x4 __attribute__((ext_vector_type(4)));
constexpr int BM = 256, BK = 64, HALF = 128, HTB = HALF * BK * 2  , STAGE_BYTES = 8 * HTB, NXCD = 8, WGM = 8;

__host__ __device__ __forceinline__ int lds_byte(int r, int c) { const int st = (r >> 4) * 2 + (c >> 5), rr = r & 15, cc = c & 31, ob = rr * 64 + cc * 2; return st * 1024 + (ob ^ (((ob >> 9) & 1) << 5)); }
__host__ __device__ __forceinline__ void stage_rc(int b, int& R, int& C) { const int st = b / 1024, sb = b % 1024, swz = sb ^ (((sb >> 9) & 1) << 5); R = (st >> 1) * 16 + swz / 64; C = (st & 1) * 32 + (swz % 64) / 2; }
__host__ __device__ __forceinline__ int perm32(int rho) { const int n = rho >> 4, i = rho & 15; return 8 * (i >> 2) + 4 * n + (i & 3); }

struct Unit { int pm, pn; };
struct Gemm { const bf16_t* A; const bf16_t* Bt; int M, N, K, ld; };

struct StaticOrder {
    int nM, nN, nwg, G, c;
    __host__ __device__ void init(int M, int N, int G_, int c_) { nM = M / BM; nN = N / BM; nwg = nM * nN; G = G_; c = c_; }
    __host__ __device__ bool next(int i, Unit& u) const {
        const long L = (long)i * G + c; if (L >= nwg) return false;
        int wgid = (int)L; { const int q = nwg / NXCD, r = nwg % NXCD, xcd = wgid % NXCD, off = wgid / NXCD; wgid = (xcd < r ? xcd * (q + 1) : r * (q + 1) + (xcd - r) * q) + off; }
        const int nig = WGM * nN, gid = wgid / nig, fm = gid * WGM, gsz = (nM - fm) < WGM ? (nM - fm) : WGM;
        u.pm = fm + ((wgid % nig) % gsz); u.pn = (wgid % nig) / gsz; return true;
    }
    __device__ __forceinline__ void a_ready(const Unit&) const {}
    __device__ __forceinline__ void done(const Unit&) const {}
};

__device__ __forceinline__ unsigned cvt_pk_bf16(float lo, float hi) { unsigned r; asm volatile("v_cvt_pk_bf16_f32 %0, %1, %2" : "=v"(r) : "v"(lo), "v"(hi)); return r; }
typedef float f32x2 __attribute__((ext_vector_type(2)));
struct EpiBf16 {
    static constexpr bool PERM = true, AFTER_DRAIN = false;
    bf16_t* O; int ldc;
    __device__ __forceinline__ void operator()(const f32x4 (&acc)[2][2][4][2], const Unit& u, int wr, int wc, int fr, int fq) const {
        const int row0 = u.pm * BM + wr * 64 + fr; const int col0 = u.pn * BM + wc * 32 + 8 * fq;
#pragma unroll
        for (int ai = 0; ai < 2; ++ai)
#pragma unroll
            for (int m = 0; m < 4; ++m) { bf16_t* rowp = O + (size_t)(row0 + ai * HALF + m * 16) * ldc + col0;
#pragma unroll
                for (int bj = 0; bj < 2; ++bj) { const f32x4 v0 = acc[ai][bj][m][0], v1 = acc[ai][bj][m][1];
                    u32x4 w; w.x = cvt_pk_bf16(v0[0], v0[1]); w.y = cvt_pk_bf16(v0[2], v0[3]); w.z = cvt_pk_bf16(v1[0], v1[1]); w.w = cvt_pk_bf16(v1[2], v1[3]);
                    *(u32x4*)(rowp + bj * HALF) = w; } }
    }
    __device__ __forceinline__ void fused(f32x4 (&)[2][2][4][2], const Unit&, int, int, int, int, PG8_LAS unsigned char*, int, int) const {}
};

struct OneUnit {
    int pn; bool has;
    __device__ bool next(int i, Unit& u) const { if (i != 0 || !has) return false; u.pm = 0; u.pn = pn; return true; }
    __device__ __forceinline__ void a_ready(const Unit&) const {}
    __device__ __forceinline__ void done(const Unit&) const {}
};
struct EpiF32 {
    static constexpr bool PERM = true, AFTER_DRAIN = false;
    float* slab; int N, split;
    __device__ __forceinline__ void operator()(const f32x4 (&acc)[2][2][4][2], const Unit& u, int wr, int wc, int fr, int fq) const {
        const int row0 = wr * 64 + fr, col0 = u.pn * BM + wc * 32 + 8 * fq;
        float* sl = slab + (size_t)split * 256 * N;
#pragma unroll
        for (int ai = 0; ai < 2; ++ai)
#pragma unroll
            for (int m = 0; m < 4; ++m) { float* rowp = sl + (size_t)(row0 + ai * HALF + m * 16) * N + col0;
#pragma unroll
                for (int bj = 0; bj < 2; ++bj) { *(f32x4*)(rowp + bj * HALF) = acc[ai][bj][m][0]; *(f32x4*)(rowp + bj * HALF + 4) = acc[ai][bj][m][1]; } }
    }
    __device__ __forceinline__ void fused(f32x4 (&)[2][2][4][2], const Unit&, int, int, int, int, PG8_LAS unsigned char*, int, int) const {}
};

struct EpiProj {
    static constexpr bool PERM = true, AFTER_DRAIN = false;
    bf16_t* O; int ldc; const float* tab;
    __device__ __forceinline__ void operator()(const f32x4 (&acc)[2][2][4][2], const Unit& u, int wr_, int wc_, int fr_, int fq_) const {
        int t_ = threadIdx.x; asm volatile("" : "+v"(t_));
        const int wid_ = t_ >> 6, lane_ = t_ & 63, wr = wid_ >> 2, wc = wid_ & 3, fr = lane_ & 15, fq = lane_ >> 4; (void)wr_; (void)wc_; (void)fr_; (void)fq_;
        const int row0 = u.pm * BM + wr * 64 + fr;
        if (u.pn >= 8) {
            const int col0 = u.pn * BM + wc * 32 + 8 * fq;
#pragma unroll
            for (int ai = 0; ai < 2; ++ai)
#pragma unroll
                for (int m = 0; m < 4; ++m) { bf16_t* rowp = O + (size_t)(row0 + ai * HALF + m * 16) * ldc + col0;
#pragma unroll
                    for (int bj = 0; bj < 2; ++bj) { const f32x4 v0 = acc[ai][bj][m][0], v1 = acc[ai][bj][m][1];
                        u32x4 w; w.x = cvt_pk_bf16(v0[0], v0[1]); w.y = cvt_pk_bf16(v0[2], v0[3]); w.z = cvt_pk_bf16(v1[0], v1[1]); w.w = cvt_pk_bf16(v1[2], v1[3]);
                        *(u32x4*)(rowp + bj * HALF) = w; } }
            return;
        }
        typedef unsigned u32x2 __attribute__((ext_vector_type(2)));
        const int p = wc >> 1, i0 = ((wc & 1) * 4 + fq) * 4; const bool rope = u.pm >= 1;
#pragma unroll
        for (int ai = 0; ai < 2; ++ai)
#pragma unroll
            for (int m = 0; m < 4; ++m) { const int row = row0 + ai * HALF + m * 16; const int t = row - 256;
                f32x4 c01 = {1.f, 0.f, 1.f, 0.f}, c23 = {1.f, 0.f, 1.f, 0.f};
                if (rope) { const float* tb = tab + ((size_t)(p ? 256 + (t & 63) : (t >> 6)) * 32 + i0) * 2; c01 = *(const f32x4*)tb; c23 = *(const f32x4*)(tb + 4); }
                bf16_t* rowp = O + (size_t)row * ldc + u.pn * BM + p * 64 + i0;
#pragma unroll
                for (int bj = 0; bj < 2; ++bj) { const f32x4 x1 = acc[ai][bj][m][0], x2 = acc[ai][bj][m][1];
                    u32x2 a, b;
                    a.x = cvt_pk_bf16(x1[0] * c01[0] - x2[0] * c01[1], x1[1] * c01[2] - x2[1] * c01[3]); a.y = cvt_pk_bf16(x1[2] * c23[0] - x2[2] * c23[1], x1[3] * c23[2] - x2[3] * c23[3]);
                    b.x = cvt_pk_bf16(x2[0] * c01[0] + x1[0] * c01[1], x2[1] * c01[2] + x1[1] * c01[3]); b.y = cvt_pk_bf16(x2[2] * c23[0] + x1[2] * c23[1], x2[3] * c23[2] + x1[3] * c23[3]);
                    *(u32x2*)(rowp + bj * HALF) = a; *(u32x2*)(rowp + bj * HALF + 32) = b; } }
    }
    __device__ __forceinline__ void fused(f32x4 (&)[2][2][4][2], const Unit&, int, int, int, int, PG8_LAS unsigned char*, int, int) const {}
};
template <class Epi, class Sched, bool ALIGN_EPI = false, bool SP2 = false>
__device__ __forceinline__ void gemm_phase(PG8_LAS unsigned char* lds, const Gemm g, const Sched& S, const Epi& E) {
    int tid = threadIdx.x; asm volatile("" : "+v"(tid));
    const int wid = __builtin_amdgcn_readfirstlane(tid >> 6), lane = tid & 63, wr = wid >> 2, wc = wid & 3, fr = lane & 15, fq = lane >> 4;
    const int K = g.ld, nt = g.K / BK;
    unsigned voffA[2], voffB[2];
#pragma unroll
    for (int i = 0; i < 2; ++i) { int R, C; stage_rc(tid * 16 + i * 8192, R, C); const int Rb = Epi::PERM ? ((R & ~31) + perm32(R & 31)) : R;
        voffA[i] = (unsigned)(R * K + C) * 2u; voffB[i] = (unsigned)(Rb * K + C) * 2u; }
    const size_t kstep = (size_t)(BK * 2);
    const size_t hstep = (size_t)HALF * K * 2;
    const size_t tstep = 2 * hstep;
    const unsigned ldsw = (unsigned)wid * 1024u;
    const int aoff = lds_byte(wr * 64 + fr, fq * 8), boff = lds_byte(wc * 32 + fr, fq * 8);
#define PG8_SA(b, h) (((b) * 2 + (h)) * HTB)
#define PG8_SB(b, h) ((4 + (b) * 2 + (h)) * HTB)
#define PG8_STAGE(bufoff, gbase, voff) do { _Pragma("unroll") for (int _i = 0; _i < 2; ++_i) \
        __builtin_amdgcn_global_load_lds((const unsigned*)((const char*)(gbase) + (voff)[_i]), (PG8_LAS unsigned*)(lds + (bufoff) + ldsw + _i * 8192), 16, 0, 0); } while (0)
#define PG8_LDA(dst, b, h) do { _Pragma("unroll") for (int m = 0; m < 4; ++m) _Pragma("unroll") for (int k = 0; k < 2; ++k) dst[m][k] = *(const PG8_LAS bf16x8*)(lds + PG8_SA(b, h) + aoff + m * 2048 + k * 1024); } while (0)
#define PG8_LDB(dst, b, h) do { _Pragma("unroll") for (int n = 0; n < 2; ++n) _Pragma("unroll") for (int k = 0; k < 2; ++k) dst[n][k] = *(const PG8_LAS bf16x8*)(lds + PG8_SB(b, h) + boff + n * 2048 + k * 1024); } while (0)
#define PG8_MMA(ai, bj, At, Bt) do { __builtin_amdgcn_s_setprio(1); _Pragma("unroll") for (int m = 0; m < 4; ++m) _Pragma("unroll") for (int n = 0; n < 2; ++n) _Pragma("unroll") for (int k = 0; k < 2; ++k) \
        acc[ai][bj][m][n] = __builtin_amdgcn_mfma_f32_16x16x32_bf16(Bt[n][k], At[m][k], acc[ai][bj][m][n], 0, 0, 0); __builtin_amdgcn_s_setprio(0); } while (0)
#define PG8_WAIT_V(n) asm volatile("s_waitcnt vmcnt(" #n ")" ::: "memory")
#define PG8_WAIT_L(n) asm volatile("s_waitcnt lgkmcnt(" #n ")" ::: "memory")
#define PG8_BAR __builtin_amdgcn_s_barrier()
#define PG8_SCHED __builtin_amdgcn_sched_barrier(0)
    Unit cur, nxt; int ui = 0;
    if (!S.next(0, cur)) return;
    f32x4 acc[2][2][4][2];
#pragma unroll
    for (int a = 0; a < 2; ++a)
#pragma unroll
        for (int b = 0; b < 2; ++b)
#pragma unroll
            for (int m = 0; m < 4; ++m)
#pragma unroll
                for (int n = 0; n < 2; ++n) acc[a][b][m][n] = (f32x4){0.f, 0.f, 0.f, 0.f};
    bf16x8 At[4][2], B0[2][2], B1[2][2];
    const char* cA = (const char*)g.A + (size_t)cur.pm * tstep; const char* cB = (const char*)g.Bt + (size_t)cur.pn * tstep;
    S.a_ready(cur);
    if constexpr (SP2) {
        PG8_STAGE(PG8_SB(0, 0), cB, voffB); PG8_STAGE(PG8_SB(0, 1), cB + hstep, voffB); PG8_STAGE(PG8_SA(0, 0), cA, voffA); PG8_STAGE(PG8_SA(0, 1), cA + hstep, voffA);
        if (wr == 1) PG8_BAR;
        PG8_WAIT_V(2); PG8_BAR;
        PG8_STAGE(PG8_SB(1, 0), cB + kstep, voffB); PG8_STAGE(PG8_SA(1, 0), cA + kstep, voffA); PG8_STAGE(PG8_SB(1, 1), cB + hstep + kstep, voffB);
        PG8_WAIT_V(6); PG8_BAR;
    } else {
        PG8_STAGE(PG8_SB(0, 0), cB, voffB); PG8_STAGE(PG8_SA(0, 0), cA, voffA); PG8_STAGE(PG8_SB(0, 1), cB + hstep, voffB); PG8_STAGE(PG8_SA(0, 1), cA + hstep, voffA);
        if (wr == 1) PG8_BAR;
        PG8_WAIT_V(4); PG8_BAR;
        PG8_STAGE(PG8_SB(1, 0), cB + kstep, voffB); PG8_STAGE(PG8_SA(1, 0), cA + kstep, voffA); PG8_STAGE(PG8_SB(1, 1), cB + hstep + kstep, voffB);
        PG8_WAIT_V(6); PG8_BAR;
    }
    for (;;) {
        const bool has_next = S.next(ui + 1, nxt);
        const char* nA = has_next ? (const char*)g.A + (size_t)nxt.pm * tstep : cA; const char* nB = has_next ? (const char*)g.Bt + (size_t)nxt.pn * tstep : cB;
        for (int t = 0; t < nt; t += 2) {
            const bool last = (t == nt - 2);
            const char* a1 = cA + (size_t)(t + 1) * kstep;
            const char* a2 = last ? nA : cA + (size_t)(t + 2) * kstep; const char* b2 = last ? nB : cB + (size_t)(t + 2) * kstep;
            const char* a3 = a2 + kstep; const char* b3 = b2 + kstep;
            if (last && has_next) S.a_ready(nxt);
            if constexpr (SP2) {
            PG8_LDB(B0, 0, 0); PG8_LDB(B1, 0, 1); PG8_SCHED; PG8_LDA(At, 0, 0); PG8_STAGE(PG8_SA(1, 1), a1 + hstep, voffA);
            PG8_WAIT_V(8); PG8_WAIT_L(0); PG8_BAR; PG8_MMA(0, 0, At, B0); PG8_MMA(0, 1, At, B1); PG8_BAR; PG8_SCHED;
            PG8_LDA(At, 0, 1); PG8_STAGE(PG8_SB(0, 0), b2, voffB); PG8_STAGE(PG8_SB(0, 1), b2 + hstep, voffB); PG8_STAGE(PG8_SA(0, 0), a2, voffA);
            PG8_WAIT_V(8); PG8_WAIT_L(0); PG8_BAR; PG8_MMA(1, 0, At, B0); PG8_MMA(1, 1, At, B1); PG8_BAR; PG8_SCHED;
            PG8_LDB(B0, 1, 0); PG8_LDB(B1, 1, 1); PG8_SCHED; PG8_LDA(At, 1, 0); PG8_STAGE(PG8_SA(0, 1), a2 + hstep, voffA);
            PG8_WAIT_V(8); PG8_WAIT_L(0); PG8_BAR; PG8_MMA(0, 0, At, B0); PG8_MMA(0, 1, At, B1); PG8_BAR; PG8_SCHED;
            PG8_LDA(At, 1, 1); PG8_STAGE(PG8_SB(1, 0), b3, voffB); PG8_STAGE(PG8_SB(1, 1), b3 + hstep, voffB); PG8_STAGE(PG8_SA(1, 0), a3, voffA);
            PG8_WAIT_V(8); PG8_WAIT_L(0); PG8_BAR; PG8_MMA(1, 0, At, B0); PG8_MMA(1, 1, At, B1); PG8_BAR; PG8_SCHED;
            } else {
            PG8_LDB(B0, 0, 0); PG8_SCHED; PG8_LDA(At, 0, 0); PG8_STAGE(PG8_SA(1, 1), a1 + hstep, voffA);
            PG8_WAIT_L(8); PG8_BAR; PG8_WAIT_L(0); PG8_MMA(0, 0, At, B0); PG8_BAR; PG8_SCHED;
            PG8_LDB(B1, 0, 1); PG8_STAGE(PG8_SB(0, 0), b2, voffB);
            PG8_BAR; PG8_WAIT_L(0); PG8_MMA(0, 1, At, B1); PG8_BAR;
            PG8_LDA(At, 0, 1); PG8_STAGE(PG8_SA(0, 0), a2, voffA);
            PG8_BAR; PG8_WAIT_L(0); PG8_MMA(1, 0, At, B0); PG8_BAR; PG8_SCHED;
            PG8_STAGE(PG8_SB(0, 1), b2 + hstep, voffB);
            PG8_WAIT_V(6); PG8_BAR; PG8_MMA(1, 1, At, B1); PG8_BAR;
            PG8_LDB(B0, 1, 0); PG8_SCHED; PG8_LDA(At, 1, 0); PG8_STAGE(PG8_SA(0, 1), a2 + hstep, voffA);
            PG8_WAIT_L(8); PG8_BAR; PG8_WAIT_L(0); PG8_MMA(0, 0, At, B0); PG8_BAR; PG8_SCHED;
            PG8_LDB(B1, 1, 1); PG8_STAGE(PG8_SB(1, 0), b3, voffB);
            PG8_BAR; PG8_WAIT_L(0); PG8_MMA(0, 1, At, B1); PG8_BAR;
            PG8_LDA(At, 1, 1); PG8_STAGE(PG8_SA(1, 0), a3, voffA);
            PG8_BAR; PG8_WAIT_L(0); PG8_MMA(1, 0, At, B0); PG8_BAR; PG8_SCHED;
            PG8_STAGE(PG8_SB(1, 1), b3 + hstep, voffB);
            PG8_WAIT_V(6); PG8_BAR; PG8_MMA(1, 1, At, B1); PG8_BAR;
            }
        }
        if constexpr (ALIGN_EPI) { if (wr == 0) PG8_BAR; }
        if constexpr (!Epi::AFTER_DRAIN) { E(acc, cur, wr, wc, fr, fq); S.done(cur); }
        if (!has_next) break;
#pragma unroll
        for (int a = 0; a < 2; ++a)
#pragma unroll
            for (int b = 0; b < 2; ++b)
#pragma unroll
                for (int m = 0; m < 4; ++m)
#pragma unroll
                    for (int n = 0; n < 2; ++n) acc[a][b][m][n] = (f32x4){0.f, 0.f, 0.f, 0.f};
        cur = nxt; cA = nA; cB = nB; ++ui;
        if constexpr (ALIGN_EPI) { if (wr == 1) PG8_BAR; }
    }
    PG8_WAIT_V(0);
    if constexpr (!ALIGN_EPI) { if (wr == 0) PG8_BAR; }
    PG8_BAR;
    if constexpr (Epi::AFTER_DRAIN) { E.fused(acc, cur, wr, wc, fr, fq, lds, wid, lane); S.done(cur); }
#undef PG8_SA
#undef PG8_SB
#undef PG8_STAGE
#undef PG8_LDA
#undef PG8_LDB
#undef PG8_MMA
#undef PG8_WAIT_V
#undef PG8_WAIT_L
#undef PG8_BAR
#undef PG8_SCHED
}
}
namespace att {
typedef unsigned short bf16_t;
using bf16x8 = __attribute__((ext_vector_type(8))) short;
using s16x4  = __attribute__((ext_vector_type(4))) short;
using f32x16 = __attribute__((ext_vector_type(16))) float;
using u32x4  = __attribute__((ext_vector_type(4))) unsigned;
using f32x4  = __attribute__((ext_vector_type(4))) float;
constexpr int   D = 128, NW = 8, QBLK = 32, KVBLK = 64;
constexpr float SCALE = 0.088388347648318440f;
constexpr float THR = 8.f;
constexpr int LDP = 6144;
constexpr int LDO = 2048;
constexpr int SHM_V = KVBLK * D * 2, SHM_K = KVBLK * D * 2;
constexpr int SHM_WS_OFF = 2 * SHM_V + 2 * SHM_K, SHM_RPB_OFF = SHM_WS_OFF + NW * 64 * 4, SHM_ATTN = SHM_RPB_OFF + 2048;
constexpr int RPB_N = 15 * 31;

struct Unit {
  const bf16_t* Q; const bf16_t* K; const bf16_t* V;
  float* Of; bf16_t* Ob;
  const float* natab;
  int nt, nsplit, base1;
  int na, qrow0, kr0;
};

#define KSWZ(row, colB) ((row) * 256 + ((colB) ^ (((row) & 7) << 4)))
#define SBAR() __builtin_amdgcn_sched_barrier(0)
__device__ __forceinline__ int crow(int r, int hi) { return (r & 3) + 8 * (r >> 2) + 4 * hi; }
__device__ __forceinline__ unsigned cvtpk(float lo, float hi) { unsigned r; asm volatile("v_cvt_pk_bf16_f32 %0, %1, %2" : "=v"(r) : "v"(lo), "v"(hi)); return r; }
__device__ __forceinline__ bf16x8 ld8(const bf16_t* p) { return *reinterpret_cast<const bf16x8*>(p); }

__device__ __forceinline__ void partialSM(f32x16& p0, f32x16& p1, float& m_reg, float& mn, float& alpha) {
  constexpr float C = SCALE * 1.4426950408889634f;
  float pmax = p0[0];
#pragma unroll
  for (int r = 1; r < 16; ++r) pmax = fmaxf(pmax, p0[r]);
#pragma unroll
  for (int r = 0; r < 16; ++r) pmax = fmaxf(pmax, p1[r]);
  { auto rr = __builtin_amdgcn_permlane32_swap(__float_as_uint(pmax), __float_as_uint(pmax), false, false);
    pmax = fmaxf(__uint_as_float(rr[0]), __uint_as_float(rr[1])); }
  if (__builtin_expect(__all(pmax - m_reg <= THR / SCALE), 1)) { mn = m_reg; alpha = 1.f; }
  else { mn = fmaxf(m_reg, pmax); alpha = __builtin_amdgcn_exp2f((m_reg - mn) * C); m_reg = mn; }
  float mnC = -mn * C;
#pragma unroll
  for (int r = 0; r < 16; ++r) p0[r] = fmaf(p0[r], C, mnC);
#pragma unroll
  for (int r = 0; r < 16; ++r) p1[r] = fmaf(p1[r], C, mnC);
#pragma unroll
  for (int r = 0; r < 16; ++r) p0[r] = __builtin_amdgcn_exp2f(p0[r]);
}
__device__ __forceinline__ void finishSM(f32x16& p0, f32x16& p1, float alpha, float& l_reg, bf16x8& pa0, bf16x8& pa1, bf16x8& pa2, bf16x8& pa3) {
#pragma unroll
  for (int r = 0; r < 16; ++r) p1[r] = __builtin_amdgcn_exp2f(p1[r]);
  float ps = 0;
#pragma unroll
  for (int r = 0; r < 16; ++r) ps += p0[r];
#pragma unroll
  for (int r = 0; r < 16; ++r) ps += p1[r];
  { auto rr = __builtin_amdgcn_permlane32_swap(__float_as_uint(ps), __float_as_uint(ps), false, false);
    ps = __uint_as_float(rr[0]) + __uint_as_float(rr[1]); }
  l_reg = l_reg * alpha + ps;
#define PK4(P, BASE, OUT) do { unsigned a0 = cvtpk(P[BASE + 0], P[BASE + 1]), a1 = cvtpk(P[BASE + 2], P[BASE + 3]);   \
    unsigned b0 = cvtpk(P[BASE + 4], P[BASE + 5]), b1 = cvtpk(P[BASE + 6], P[BASE + 7]);                              \
    auto r0 = __builtin_amdgcn_permlane32_swap(a0, b0, false, false); auto r1 = __builtin_amdgcn_permlane32_swap(a1, b1, false, false); \
    u32x4 w = {r0[0], r1[0], r0[1], r1[1]}; OUT = *reinterpret_cast<bf16x8*>(&w); } while (0)
  PK4(p0, 0, pa0); PK4(p0, 8, pa1); PK4(p1, 0, pa2); PK4(p1, 8, pa3);
#undef PK4
}
__device__ __forceinline__ void qkt(f32x16& p0, f32x16& p1, const bf16_t* Ks, const bf16x8* qr, int r32, int hi) {
#pragma unroll
  for (int d0 = 0; d0 < 8; ++d0) { int cb = (d0 * 16 + hi * 8) * 2;
    bf16x8 b0 = *reinterpret_cast<const bf16x8*>((const char*)Ks + KSWZ(r32, cb));
    bf16x8 b1 = *reinterpret_cast<const bf16x8*>((const char*)Ks + KSWZ(32 + r32, cb));
    p0 = __builtin_amdgcn_mfma_f32_32x32x16_bf16(b0, qr[d0], p0, 0, 0, 0);
    p1 = __builtin_amdgcn_mfma_f32_32x32x16_bf16(b1, qr[d0], p1, 0, 0, 0); }
}
__device__ __forceinline__ int v_st(int k, int c) { const int kk = (k & ~0xC) | ((k & 4) << 1) | ((k & 8) >> 1); return ((kk >> 3) * 4 + (c >> 5)) * 512 + ((kk & 7) * 32 + (c & 31)) * 2; }
__device__ __forceinline__ int v_rd_base(int lane) { return ((lane & 3) << 3) | (((lane >> 2) & 3) << 6) | (((lane >> 4) & 1) << 5) | (((lane >> 5) & 1) << 8); }
constexpr int v_rd_off(int d0, int ks, int half) { return d0 * 512 + ks * 4096 + half * 2048; }
template <int OFF> __device__ __forceinline__ s16x4 tr_read(int vb) {
  s16x4 r; asm volatile("ds_read_b64_tr_b16 %0, %1 offset:%2" : "=&v"(r) : "v"(vb), "i"(OFF) : "memory"); return r;
}
template <int D0> __device__ __forceinline__ void pv_one(f32x16& od, int vb, bf16x8 pa0, bf16x8 pa1, bf16x8 pa2, bf16x8 pa3) {
  const s16x4 l0 = tr_read<v_rd_off(D0, 0, 0)>(vb), h0 = tr_read<v_rd_off(D0, 0, 1)>(vb), l1 = tr_read<v_rd_off(D0, 1, 0)>(vb), h1 = tr_read<v_rd_off(D0, 1, 1)>(vb);
  const s16x4 l2 = tr_read<v_rd_off(D0, 2, 0)>(vb), h2 = tr_read<v_rd_off(D0, 2, 1)>(vb), l3 = tr_read<v_rd_off(D0, 3, 0)>(vb), h3 = tr_read<v_rd_off(D0, 3, 1)>(vb);
  asm volatile("s_waitcnt lgkmcnt(0)" ::: "memory"); SBAR();
#define PK(L, H) (bf16x8){L[0], L[1], L[2], L[3], H[0], H[1], H[2], H[3]}
  od = __builtin_amdgcn_mfma_f32_32x32x16_bf16(pa0, PK(l0, h0), od, 0, 0, 0);
  od = __builtin_amdgcn_mfma_f32_32x32x16_bf16(pa1, PK(l1, h1), od, 0, 0, 0);
  od = __builtin_amdgcn_mfma_f32_32x32x16_bf16(pa2, PK(l2, h2), od, 0, 0, 0);
  od = __builtin_amdgcn_mfma_f32_32x32x16_bf16(pa3, PK(l3, h3), od, 0, 0, 0);
#undef PK
}
__device__ __forceinline__ void pv_d0(f32x16* o, int vb, bf16x8 pa0, bf16x8 pa1, bf16x8 pa2, bf16x8 pa3) {
  pv_one<0>(o[0], vb, pa0, pa1, pa2, pa3); pv_one<1>(o[1], vb, pa0, pa1, pa2, pa3); pv_one<2>(o[2], vb, pa0, pa1, pa2, pa3); pv_one<3>(o[3], vb, pa0, pa1, pa2, pa3);
}
template <bool NA> __device__ __forceinline__ void acc_init(f32x16& p0, f32x16& p1, int j, const Unit& U, int wid, int r32, int hi) {
  if constexpr (!NA) { p0 = f32x16{}; p1 = f32x16{}; }
  else {
    int slice = 16;
    if (j >= U.nsplit) { const int kr = U.kr0 + (j - U.nsplit), qr_ = U.qrow0 + (wid >> 1); int rs = qr_ - 4; rs = rs < 0 ? 0 : (rs > 248 ? 248 : rs);
      slice = (kr >= rs && kr < rs + 8) ? (kr - qr_ + 7) : 15; }
    const float* tb = U.natab + (size_t)slice * 4096 + (unsigned)(((wid & 1) * 32 + r32) * 64 + 4 * hi);
#pragma unroll
    for (int q = 0; q < 4; ++q) { const f32x4 a = *(const f32x4*)(tb + 8 * q), b = *(const f32x4*)(tb + 32 + 8 * q);
      p0[4 * q + 0] = a[0]; p0[4 * q + 1] = a[1]; p0[4 * q + 2] = a[2]; p0[4 * q + 3] = a[3];
      p1[4 * q + 0] = b[0]; p1[4 * q + 1] = b[1]; p1[4 * q + 2] = b[2]; p1[4 * q + 3] = b[3]; }
  }
}

template <bool NA> __device__ __forceinline__ void unit_body(const Unit& U, char* lds) {
  int tid = threadIdx.x; asm volatile("" : "+v"(tid)); const int wid = __builtin_amdgcn_readfirstlane(tid >> 6), lane = tid & 63, r32 = lane & 31, hi = lane >> 5;
  bf16_t* V_lds = (bf16_t*)lds; bf16_t* K_lds = (bf16_t*)(lds + 2 * SHM_V);
  float* ws = (float*)(lds + SHM_WS_OFF) + wid * 64; float* li_l = ws; float* al_l = ws + 32;
  float m_reg = -1e30f, l_reg = 0; f32x16 o[4] = {}; bf16x8 qr[8];
  const bf16_t* Qw = U.Q + (long)(wid * QBLK + r32) * LDP + hi * 8;
#pragma unroll
  for (int d0 = 0; d0 < 8; ++d0) qr[d0] = ld8(Qw + d0 * 16);
  const int sr = tid >> 4, sc = (tid & 15) * 8, vst0 = v_st(sr, sc), vst1 = v_st(32 + sr, sc);
  const int vb0 = (int)(uintptr_t)V_lds + v_rd_base(lane);
  struct { bf16x8 vs0, vs1, ks0, ks1; } sr_[2];
  const int nsplit = U.nsplit, base1 = U.base1;
#define TROW(j_) ((long)((j_) < nsplit ? (j_) * KVBLK : base1 + ((j_) - nsplit) * KVBLK))
#define SLOAD(i, j_) do { const long rb_ = TROW(j_); sr_[i].vs0 = ld8(&U.V[(rb_ + sr) * LDP + sc]); sr_[i].vs1 = ld8(&U.V[(rb_ + 32 + sr) * LDP + sc]); \
    sr_[i].ks0 = ld8(&U.K[(rb_ + sr) * LDP + sc]); sr_[i].ks1 = ld8(&U.K[(rb_ + 32 + sr) * LDP + sc]); } while (0)
#define SWRITE(b, i) do { *(bf16x8*)((char*)V_lds + (b) * SHM_V + vst0) = sr_[i].vs0;          \
    *(bf16x8*)((char*)V_lds + (b) * SHM_V + vst1) = sr_[i].vs1; int kc = sc * 2;               \
    *(bf16x8*)((char*)K_lds + (b) * SHM_K + KSWZ(sr, kc)) = sr_[i].ks0;                       \
    *(bf16x8*)((char*)K_lds + (b) * SHM_K + KSWZ(32 + sr, kc)) = sr_[i].ks1; } while (0)
#define SWAIT() asm volatile("s_waitcnt vmcnt(4)" ::: "memory")
#define RESC(a) do { if (__any((a) < 1.f)) { if (hi == 0) al_l[r32] = (a); asm volatile("s_waitcnt lgkmcnt(0)" ::: "memory"); \
    _Pragma("unroll") for (int d = 0; d < 4; ++d) _Pragma("unroll") for (int r = 0; r < 16; ++r) o[d][r] *= al_l[crow(r, hi)]; } } while (0)
  f32x16 pA0, pA1, pB0, pB1; float mnA, mnB, alA, alB; bf16x8 pa0, pa1, pa2, pa3; const int NT = U.nt;
  constexpr int SE = 0, SO = 1;
  SLOAD(SE, 0); asm volatile("s_waitcnt vmcnt(0)" ::: "memory"); SWRITE(0, SE); __syncthreads();
  acc_init<NA>(pA0, pA1, 0, U, wid, r32, hi); qkt(pA0, pA1, K_lds, qr, r32, hi); partialSM(pA0, pA1, m_reg, mnA, alA);
  SLOAD(SO, 1); if (2 < NT) SLOAD(SE, 2);
  SWAIT(); SWRITE(1, SO); __syncthreads();
  for (int j = 1; j + 1 < NT; j += 2) {
    SBAR(); acc_init<NA>(pB0, pB1, j, U, wid, r32, hi); qkt(pB0, pB1, (bf16_t*)((char*)K_lds + SHM_K), qr, r32, hi);
    finishSM(pA0, pA1, alA, l_reg, pa0, pa1, pa2, pa3); SBAR();
    SLOAD(SO, j + 2); SBAR();
    pv_d0(o, vb0, pa0, pa1, pa2, pa3); partialSM(pB0, pB1, m_reg, mnB, alB);
    __syncthreads(); SWAIT(); SWRITE(0, SE);
    RESC(alB); __syncthreads();
    SBAR(); acc_init<NA>(pA0, pA1, j + 1, U, wid, r32, hi); qkt(pA0, pA1, K_lds, qr, r32, hi);
    finishSM(pB0, pB1, alB, l_reg, pa0, pa1, pa2, pa3); SBAR();
    if (j + 3 < NT) SLOAD(SE, j + 3); SBAR();
    pv_d0(o, vb0 + (int)SHM_V, pa0, pa1, pa2, pa3); partialSM(pA0, pA1, m_reg, mnA, alA);
    __syncthreads(); SWAIT(); SWRITE(1, SO);
    RESC(alA); __syncthreads();
  }
  SBAR(); acc_init<NA>(pB0, pB1, NT - 1, U, wid, r32, hi); qkt(pB0, pB1, (bf16_t*)((char*)K_lds + SHM_K), qr, r32, hi);
  finishSM(pA0, pA1, alA, l_reg, pa0, pa1, pa2, pa3); SBAR();
  pv_d0(o, vb0, pa0, pa1, pa2, pa3); partialSM(pB0, pB1, m_reg, mnB, alB);
  __syncthreads(); RESC(alB);
  finishSM(pB0, pB1, alB, l_reg, pa0, pa1, pa2, pa3); SBAR();
  pv_d0(o, vb0 + (int)SHM_V, pa0, pa1, pa2, pa3);
  if (hi == 0) li_l[r32] = l_reg; asm volatile("s_waitcnt lgkmcnt(0)" ::: "memory");
  float rli[16];
#pragma unroll
  for (int r = 0; r < 16; ++r) rli[r] = __builtin_amdgcn_rcpf(li_l[crow(r, hi)]);
  if (U.Of) {
    float* Ow = U.Of + (long)(wid * QBLK) * LDO;
#pragma unroll
    for (int r = 0; r < 16; ++r) { const int orow = crow(r, hi);
#pragma unroll
      for (int d0 = 0; d0 < 4; ++d0) Ow[(long)orow * LDO + d0 * 32 + r32] = o[d0][r] * rli[r]; }
  } else {
    bf16_t* Ow = U.Ob + (long)(wid * QBLK) * LDO;
#pragma unroll
    for (int r = 0; r < 16; ++r) { const int orow = crow(r, hi);
#pragma unroll
      for (int d0 = 0; d0 < 4; ++d0) Ow[(long)orow * LDO + d0 * 32 + r32] = (bf16_t)(cvtpk(o[d0][r] * rli[r], 0.f) & 0xffffu); }
  }
  __syncthreads();
#undef TROW
#undef SLOAD
#undef SWRITE
#undef SWAIT
#undef RESC
}

constexpr int DA_VB = 32768, DA_KB = 16384, DA_WS_OFF = 2 * DA_VB + 2 * DA_KB, SHM_DA = DA_WS_OFF + NW * 64 * 4;
template <int D0, int KS0> __device__ __forceinline__ void pv_half(f32x16& od, int vb, bf16x8 paA, bf16x8 paB) {
  constexpr int IMG = (D0 >> 2) * 16384, DD = D0 & 3;
  const s16x4 l0 = tr_read<IMG + v_rd_off(DD, KS0, 0)>(vb), h0 = tr_read<IMG + v_rd_off(DD, KS0, 1)>(vb), l1 = tr_read<IMG + v_rd_off(DD, KS0 + 1, 0)>(vb), h1 = tr_read<IMG + v_rd_off(DD, KS0 + 1, 1)>(vb);
  asm volatile("s_waitcnt lgkmcnt(0)" ::: "memory"); SBAR();
#define PK(L, H) (bf16x8){L[0], L[1], L[2], L[3], H[0], H[1], H[2], H[3]}
  od = __builtin_amdgcn_mfma_f32_32x32x16_bf16(paA, PK(l0, h0), od, 0, 0, 0);
  od = __builtin_amdgcn_mfma_f32_32x32x16_bf16(paB, PK(l1, h1), od, 0, 0, 0);
#undef PK
}
template <int D0> __device__ __forceinline__ void pv_one2(f32x16& od, int vb, bf16x8 pa0, bf16x8 pa1, bf16x8 pa2, bf16x8 pa3) {
  constexpr int IMG = (D0 >> 2) * 16384, DD = D0 & 3;
  const s16x4 l0 = tr_read<IMG + v_rd_off(DD, 0, 0)>(vb), h0 = tr_read<IMG + v_rd_off(DD, 0, 1)>(vb), l1 = tr_read<IMG + v_rd_off(DD, 1, 0)>(vb), h1 = tr_read<IMG + v_rd_off(DD, 1, 1)>(vb);
  const s16x4 l2 = tr_read<IMG + v_rd_off(DD, 2, 0)>(vb), h2 = tr_read<IMG + v_rd_off(DD, 2, 1)>(vb), l3 = tr_read<IMG + v_rd_off(DD, 3, 0)>(vb), h3 = tr_read<IMG + v_rd_off(DD, 3, 1)>(vb);
  asm volatile("s_waitcnt lgkmcnt(0)" ::: "memory"); SBAR();
#define PK(L, H) (bf16x8){L[0], L[1], L[2], L[3], H[0], H[1], H[2], H[3]}
  od = __builtin_amdgcn_mfma_f32_32x32x16_bf16(pa0, PK(l0, h0), od, 0, 0, 0);
  od = __builtin_amdgcn_mfma_f32_32x32x16_bf16(pa1, PK(l1, h1), od, 0, 0, 0);
  od = __builtin_amdgcn_mfma_f32_32x32x16_bf16(pa2, PK(l2, h2), od, 0, 0, 0);
  od = __builtin_amdgcn_mfma_f32_32x32x16_bf16(pa3, PK(l3, h3), od, 0, 0, 0);
#undef PK
}
template <int I> __device__ __forceinline__ void pv_rd(int vb, s16x4& l, s16x4& h) {
  constexpr int D0 = I >> 2, KS = I & 3, IMG = (D0 >> 2) * 16384, DD = D0 & 3;
  l = tr_read<IMG + v_rd_off(DD, KS, 0)>(vb); h = tr_read<IMG + v_rd_off(DD, KS, 1)>(vb);
}
template <int I> __device__ __forceinline__ void pv_step(f32x16* o, int vb, const bf16x8 (&pa)[4], s16x4 (&l)[3], s16x4 (&h)[3]) {
  if constexpr (I + 2 < 32) pv_rd<(I + 2 < 32 ? I + 2 : 0)>(vb, l[(I + 2) % 3], h[(I + 2) % 3]);
  if constexpr (I + 2 < 32) asm volatile("s_waitcnt lgkmcnt(4)" ::: "memory"); else if constexpr (I + 1 < 32) asm volatile("s_waitcnt lgkmcnt(2)" ::: "memory"); else asm volatile("s_waitcnt lgkmcnt(0)" ::: "memory");
  SBAR();
  const s16x4 L = l[I % 3], H = h[I % 3];
  o[I >> 2] = __builtin_amdgcn_mfma_f32_32x32x16_bf16(pa[I & 3], (bf16x8){L[0], L[1], L[2], L[3], H[0], H[1], H[2], H[3]}, o[I >> 2], 0, 0, 0);
  SBAR();
  if constexpr (I + 1 < 32) pv_step<(I + 1 < 32 ? I + 1 : 31)>(o, vb, pa, l, h);
}
__device__ __forceinline__ void pv_all_rolling(f32x16* o, int vb, bf16x8 pa0, bf16x8 pa1, bf16x8 pa2, bf16x8 pa3) {
  const bf16x8 pa[4] = {pa0, pa1, pa2, pa3}; s16x4 l[3], h[3];
  asm volatile("s_waitcnt lgkmcnt(0)" ::: "memory");
  pv_rd<0>(vb, l[0], h[0]); pv_rd<1>(vb, l[1], h[1]);
  pv_step<0>(o, vb, pa, l, h);
}
template <int OFF> __device__ __forceinline__ bf16x8 k_read(int a) { bf16x8 r; asm volatile("ds_read_b128 %0, %1 offset:%2" : "=&v"(r) : "v"(a), "i"(OFF) : "memory"); return r; }
template <int BUFOFF, int D0> __device__ __forceinline__ void qk_step(f32x16& p0, f32x16& p1, int ka0, const bf16x8 (&qr)[8], bf16x8 (&k0)[2], bf16x8 (&k1)[2]) {
  if constexpr (D0 + 1 < 8) { const int a_ = ka0 ^ ((D0 + 1) << 5); k0[(D0 + 1) & 1] = k_read<BUFOFF>(a_); k1[(D0 + 1) & 1] = k_read<BUFOFF + 8192>(a_); }
  if constexpr (D0 + 1 < 8) asm volatile("s_waitcnt lgkmcnt(2)" ::: "memory"); else asm volatile("s_waitcnt lgkmcnt(0)" ::: "memory");
  SBAR();
  p0 = __builtin_amdgcn_mfma_f32_32x32x16_bf16(k0[D0 & 1], qr[D0], p0, 0, 0, 0);
  p1 = __builtin_amdgcn_mfma_f32_32x32x16_bf16(k1[D0 & 1], qr[D0], p1, 0, 0, 0);
  SBAR();
  if constexpr (D0 + 1 < 8) qk_step<BUFOFF, (D0 + 1 < 8 ? D0 + 1 : 7)>(p0, p1, ka0, qr, k0, k1);
}
template <int BUFOFF> __device__ __forceinline__ void qkt_rolling(f32x16& p0, f32x16& p1, int ka0, const bf16x8 (&qr)[8]) {
  bf16x8 k0[2], k1[2];
  asm volatile("s_waitcnt lgkmcnt(0)" ::: "memory");
  k0[0] = k_read<BUFOFF>(ka0); k1[0] = k_read<BUFOFF + 8192>(ka0);
  qk_step<BUFOFF, 0>(p0, p1, ka0, qr, k0, k1);
}
__device__ __forceinline__ void qkt_half(f32x16& p, const char* Ks, const bf16x8* qr, int row, int hi) {
#pragma unroll
  for (int d0 = 0; d0 < 8; ++d0) { const int cb = (d0 * 16 + hi * 8) * 2;
    const bf16x8 b = *reinterpret_cast<const bf16x8*>(Ks + KSWZ(row, cb));
    p = __builtin_amdgcn_mfma_f32_32x32x16_bf16(b, qr[d0], p, 0, 0, 0); }
}
__device__ __forceinline__ void unit_body_da(const Unit& U, char* lds) {
  int tid = threadIdx.x; asm volatile("" : "+v"(tid)); const int wid = __builtin_amdgcn_readfirstlane(tid >> 6), lane = tid & 63, r32 = lane & 31, hi = lane >> 5;
  char* V_lds = lds; char* K_lds = lds + 2 * DA_VB;
  float* ws = (float*)(lds + DA_WS_OFF) + wid * 64; float* li_l = ws; float* al_l = ws + 32;
  float m_reg = -1e30f, l_reg = 0; f32x16 o[8] = {}; bf16x8 qr[8];
  const bf16_t* Qw = U.Q + (long)(wid * QBLK + r32) * LDP + hi * 8;
#pragma unroll
  for (int d0 = 0; d0 < 8; ++d0) qr[d0] = ld8(Qw + d0 * 16);
  const int vb0 = (int)(uintptr_t)V_lds + v_rd_base(lane);
  const int ka0 = (int)(uintptr_t)K_lds + KSWZ(r32, hi * 16);
  constexpr float C = SCALE * 1.4426950408889634f;
  unsigned koff[2], voff[2][2];
#pragma unroll
  for (int i = 0; i < 2; ++i) { const int ob = (2 * wid + i) * 1024 + lane * 16;
    { const int row = ob >> 8, cpos = (ob >> 4) & 15, c = cpos ^ (row & 7); koff[i] = (unsigned)(row * LDP + c * 8); }
    { const int st = ob >> 9, kk = (st >> 2) * 8 + ((ob >> 6) & 7), c = (st & 3) * 32 + ((ob >> 1) & 31), k = (kk & ~0xC) | ((kk & 4) << 1) | ((kk & 8) >> 1);
      voff[0][i] = (unsigned)(k * LDP + c); voff[1][i] = (unsigned)(k * LDP + 128 + c); } }
  typedef __attribute__((address_space(3))) unsigned lds_u32;
#define DDMA(j_, b) do { const bf16_t* kb_ = U.K + (long)(j_) * KVBLK * LDP; const bf16_t* vb__ = U.V + (long)(j_) * KVBLK * LDP; \
    _Pragma("unroll") for (int i = 0; i < 2; ++i) { \
      __builtin_amdgcn_global_load_lds((const unsigned*)(kb_ + koff[i]), (lds_u32*)(K_lds + (b) * DA_KB + (2 * wid + i) * 1024), 16, 0, 0); \
      __builtin_amdgcn_global_load_lds((const unsigned*)(vb__ + voff[0][i]), (lds_u32*)(V_lds + (b) * DA_VB + (2 * wid + i) * 1024), 16, 0, 0); \
      __builtin_amdgcn_global_load_lds((const unsigned*)(vb__ + voff[1][i]), (lds_u32*)(V_lds + (b) * DA_VB + 16384 + (2 * wid + i) * 1024), 16, 0, 0); } } while (0)
#define DPUB() do { asm volatile("s_waitcnt vmcnt(0)" ::: "memory"); __syncthreads(); } while (0)
#define DHALF(b, ROW0, paA, paB) do { f32x16 p = f32x16{}; qkt_half(p, K_lds + (b) * DA_KB, qr, (ROW0) + r32, hi); \
    float pmax = p[0]; _Pragma("unroll") for (int r = 1; r < 16; ++r) pmax = fmaxf(pmax, p[r]); \
    { auto rr = __builtin_amdgcn_permlane32_swap(__float_as_uint(pmax), __float_as_uint(pmax), false, false); pmax = fmaxf(__uint_as_float(rr[0]), __uint_as_float(rr[1])); } \
    float mn, al; if (__builtin_expect(__all(pmax - m_reg <= THR / SCALE), 1)) { mn = m_reg; al = 1.f; } else { mn = fmaxf(m_reg, pmax); al = __builtin_amdgcn_exp2f((m_reg - mn) * C); m_reg = mn; } \
    if (__any(al < 1.f)) { if (hi == 0) al_l[r32] = al; asm volatile("s_waitcnt lgkmcnt(0)" ::: "memory"); \
      _Pragma("unroll") for (int r = 0; r < 16; ++r) { const float f_ = al_l[crow(r, hi)]; _Pragma("unroll") for (int d = 0; d < 8; ++d) o[d][r] *= f_; } } \
    const float mnC = -mn * C; float ps = 0.f; \
    _Pragma("unroll") for (int r = 0; r < 16; ++r) { p[r] = __builtin_amdgcn_exp2f(fmaf(p[r], C, mnC)); ps += p[r]; } \
    { auto rr = __builtin_amdgcn_permlane32_swap(__float_as_uint(ps), __float_as_uint(ps), false, false); ps = __uint_as_float(rr[0]) + __uint_as_float(rr[1]); } \
    l_reg = l_reg * al + ps; \
    { unsigned a0 = cvtpk(p[0], p[1]), a1 = cvtpk(p[2], p[3]), b0 = cvtpk(p[4], p[5]), b1 = cvtpk(p[6], p[7]); \
      auto r0 = __builtin_amdgcn_permlane32_swap(a0, b0, false, false); auto r1 = __builtin_amdgcn_permlane32_swap(a1, b1, false, false); u32x4 w = {r0[0], r1[0], r0[1], r1[1]}; paA = *reinterpret_cast<bf16x8*>(&w); } \
    { unsigned a0 = cvtpk(p[8], p[9]), a1 = cvtpk(p[10], p[11]), b0 = cvtpk(p[12], p[13]), b1 = cvtpk(p[14], p[15]); \
      auto r0 = __builtin_amdgcn_permlane32_swap(a0, b0, false, false); auto r1 = __builtin_amdgcn_permlane32_swap(a1, b1, false, false); u32x4 w = {r0[0], r1[0], r0[1], r1[1]}; paB = *reinterpret_cast<bf16x8*>(&w); } } while (0)
#define DPV(b, KS0, paA, paB) do { const int vb_ = vb0 + (b) * DA_VB; \
    pv_half<0, KS0>(o[0], vb_, paA, paB); pv_half<1, KS0>(o[1], vb_, paA, paB); pv_half<2, KS0>(o[2], vb_, paA, paB); pv_half<3, KS0>(o[3], vb_, paA, paB); \
    pv_half<4, KS0>(o[4], vb_, paA, paB); pv_half<5, KS0>(o[5], vb_, paA, paB); pv_half<6, KS0>(o[6], vb_, paA, paB); pv_half<7, KS0>(o[7], vb_, paA, paB); } while (0)
#define DRESC(a) do { if (__any((a) < 1.f)) { if (hi == 0) al_l[r32] = (a); asm volatile("s_waitcnt lgkmcnt(0)" ::: "memory"); \
    _Pragma("unroll") for (int r = 0; r < 16; ++r) { const float f_ = al_l[crow(r, hi)]; _Pragma("unroll") for (int d = 0; d < 8; ++d) o[d][r] *= f_; } } } while (0)
#define DTILE(b) do { f32x16 p0 = f32x16{}, p1 = f32x16{}; float mn, al; bf16x8 pa0, pa1, pa2, pa3; \
    qkt_rolling<(b) * DA_KB>(p0, p1, ka0, qr); partialSM(p0, p1, m_reg, mn, al); DRESC(al); finishSM(p0, p1, al, l_reg, pa0, pa1, pa2, pa3); SBAR(); \
    pv_all_rolling(o, vb0 + (b) * DA_VB, pa0, pa1, pa2, pa3); } while (0)
  const int NT = U.nt;
  DDMA(0, 0); DPUB();
  for (int j = 0; j < NT; j += 2) {
    DDMA(j + 1, 1); SBAR();
    DTILE(0); SBAR(); DPUB();
    if (j + 2 < NT) DDMA(j + 2, 0); SBAR();
    DTILE(1); SBAR(); DPUB();
  }
  if (hi == 0) li_l[r32] = l_reg; asm volatile("s_waitcnt lgkmcnt(0)" ::: "memory");
  float* Ow = U.Of + (long)(wid * QBLK) * LDO;
#pragma unroll
  for (int r = 0; r < 16; ++r) { const int orow = crow(r, hi); const float rl = __builtin_amdgcn_rcpf(li_l[orow]);
#pragma unroll
    for (int d0 = 0; d0 < 8; ++d0) Ow[(long)orow * LDO + d0 * 32 + r32] = o[d0][r] * rl; }
  __syncthreads();
#undef DDMA
#undef DPUB
#undef DHALF
#undef DPV
#undef DTILE
#undef DRESC
}

template <int I> __device__ __forceinline__ void pv4_step(f32x16* o, int vb, const bf16x8 (&pa)[4], s16x4 (&l)[3], s16x4 (&h)[3]) {
  if constexpr (I + 2 < 16) pv_rd<(I + 2 < 16 ? I + 2 : 0)>(vb, l[(I + 2) % 3], h[(I + 2) % 3]);
  if constexpr (I + 2 < 16) asm volatile("s_waitcnt lgkmcnt(4)" ::: "memory"); else if constexpr (I + 1 < 16) asm volatile("s_waitcnt lgkmcnt(2)" ::: "memory"); else asm volatile("s_waitcnt lgkmcnt(0)" ::: "memory");
  SBAR();
  const s16x4 L = l[I % 3], H = h[I % 3];
  o[I >> 2] = __builtin_amdgcn_mfma_f32_32x32x16_bf16(pa[I & 3], (bf16x8){L[0], L[1], L[2], L[3], H[0], H[1], H[2], H[3]}, o[I >> 2], 0, 0, 0);
  SBAR();
  if constexpr (I + 1 < 16) pv4_step<(I + 1 < 16 ? I + 1 : 15)>(o, vb, pa, l, h);
}
template <bool NA> __device__ __forceinline__ void unit_body_v128(const Unit& U, char* lds) {
  int tid = threadIdx.x; asm volatile("" : "+v"(tid)); const int wid = __builtin_amdgcn_readfirstlane(tid >> 6), lane = tid & 63, r32 = lane & 31, hi = lane >> 5;
  char* V_lds = lds; char* K_lds = lds + 2 * DA_VB;
  float* ws = (float*)(lds + DA_WS_OFF) + wid * 64; float* li_l = ws; float* al_l = ws + 32;
  float m_reg = -1e30f, l_reg = 0; f32x16 o[4] = {}; bf16x8 qr[8];
  const bf16_t* Qw = U.Q + (long)(wid * QBLK + r32) * LDP + hi * 8;
#pragma unroll
  for (int d0 = 0; d0 < 8; ++d0) qr[d0] = ld8(Qw + d0 * 16);
  const int vb0 = (int)(uintptr_t)V_lds + v_rd_base(lane);
  const int ka0 = (int)(uintptr_t)K_lds + KSWZ(r32, hi * 16);
  unsigned koff[2], voff[2];
#pragma unroll
  for (int i = 0; i < 2; ++i) { const int ob = (2 * wid + i) * 1024 + lane * 16;
    { const int row = ob >> 8, cpos = (ob >> 4) & 15, c = cpos ^ (row & 7); koff[i] = (unsigned)(row * LDP + c * 8); }
    { const int st = ob >> 9, kk = (st >> 2) * 8 + ((ob >> 6) & 7), c = (st & 3) * 32 + ((ob >> 1) & 31), k = (kk & ~0xC) | ((kk & 4) << 1) | ((kk & 8) >> 1); voff[i] = (unsigned)(k * LDP + c); } }
  typedef __attribute__((address_space(3))) unsigned lds_u32;
  const int nsplit = U.nsplit, base1 = U.base1;
#define NROW(j_) ((long)((j_) < nsplit ? (j_) * KVBLK : base1 + ((j_) - nsplit) * KVBLK))
#define NDMA(j_, b) do { const long rb_ = NROW(j_); const bf16_t* kb_ = U.K + rb_ * LDP; const bf16_t* vb__ = U.V + rb_ * LDP; \
    _Pragma("unroll") for (int i = 0; i < 2; ++i) { \
      __builtin_amdgcn_global_load_lds((const unsigned*)(kb_ + koff[i]), (lds_u32*)(K_lds + (b) * DA_KB + (2 * wid + i) * 1024), 16, 0, 0); \
      __builtin_amdgcn_global_load_lds((const unsigned*)(vb__ + voff[i]), (lds_u32*)(V_lds + (b) * DA_VB + (2 * wid + i) * 1024), 16, 0, 0); } } while (0)
#define NPUB() do { asm volatile("s_waitcnt vmcnt(0)" ::: "memory"); __syncthreads(); } while (0)
#define NRESC(a) do { if (__any((a) < 1.f)) { if (hi == 0) al_l[r32] = (a); asm volatile("s_waitcnt lgkmcnt(0)" ::: "memory"); \
    _Pragma("unroll") for (int r = 0; r < 16; ++r) { const float f_ = al_l[crow(r, hi)]; _Pragma("unroll") for (int d = 0; d < 4; ++d) o[d][r] *= f_; } } } while (0)
#define NTILE(b) do { float mn, al; bf16x8 pa0, pa1, pa2, pa3; \
    qkt_rolling<(b) * DA_KB>(p0, p1, ka0, qr); partialSM(p0, p1, m_reg, mn, al); NRESC(al); finishSM(p0, p1, al, l_reg, pa0, pa1, pa2, pa3); SBAR(); \
    { const bf16x8 pa[4] = {pa0, pa1, pa2, pa3}; s16x4 l[3], h[3]; const int vb_ = vb0 + (b) * DA_VB; asm volatile("s_waitcnt lgkmcnt(0)" ::: "memory"); \
      pv_rd<0>(vb_, l[0], h[0]); pv_rd<1>(vb_, l[1], h[1]); pv4_step<0>(o, vb_, pa, l, h); } } while (0)
  const int NT = U.nt;
  NDMA(0, 0); NPUB();
  for (int j = 0; j < NT; j += 2) {
    f32x16 p0, p1;
    acc_init<NA>(p0, p1, j, U, wid, r32, hi); SBAR();
    NDMA(j + 1, 1); SBAR();
    NTILE(0); SBAR(); NPUB();
    acc_init<NA>(p0, p1, j + 1, U, wid, r32, hi); SBAR();
    if (j + 2 < NT) NDMA(j + 2, 0); SBAR();
    NTILE(1); SBAR(); NPUB();
  }
  if (hi == 0) li_l[r32] = l_reg; asm volatile("s_waitcnt lgkmcnt(0)" ::: "memory");
  if (U.Of) {
    float* Ow = U.Of + (long)(wid * QBLK) * LDO;
#pragma unroll
    for (int r = 0; r < 16; ++r) { const int orow = crow(r, hi); const float rl = __builtin_amdgcn_rcpf(li_l[orow]);
#pragma unroll
      for (int d0 = 0; d0 < 4; ++d0) Ow[(long)orow * LDO + d0 * 32 + r32] = o[d0][r] * rl; }
  } else {
    bf16_t* Ow = U.Ob + (long)(wid * QBLK) * LDO;
#pragma unroll
    for (int r = 0; r < 16; ++r) { const int orow = crow(r, hi); const float rl = __builtin_amdgcn_rcpf(li_l[orow]);
#pragma unroll
      for (int d0 = 0; d0 < 4; ++d0) Ow[(long)orow * LDO + d0 * 32 + r32] = (bf16_t)(cvtpk(o[d0][r] * rl, 0.f) & 0xffffu); }
  }
  __syncthreads();
#undef NROW
#undef NDMA
#undef NPUB
#undef NRESC
#undef NTILE
}
}
#define GAS __attribute__((address_space(1)))
#define LAS __attribute__((address_space(3)))
typedef unsigned short bf16;
typedef unsigned v4u __attribute__((ext_vector_type(4)));
typedef unsigned v2u __attribute__((ext_vector_type(2)));
typedef float f32x4 __attribute__((ext_vector_type(4)));

constexpr int DM = 2048, SEQL = 16384, LC = 256, MT = SEQL + LC;
constexpr int IN_DIM = 6144, DFF = 5632, NUP = 2 * DFF, NMOD = 6 * DM;
constexpr int NLAYER = 2;
constexpr float LN_EPS = 1e-5f;
constexpr float ALPHA = 1.41421356237309515f;

constexpr size_t MiB = 1u << 20;
constexpr size_t WS_MOD = 0;
constexpr size_t WS_BAR = 512 * 1024;
constexpr size_t WS_TICKET = WS_BAR + 16384;
constexpr size_t WS_LAMV = WS_BAR + 32768;
constexpr size_t WS_ROPE = 1 * MiB;
constexpr size_t WS_XC = 2 * MiB;
constexpr size_t WS_PART = 4 * MiB;
constexpr size_t WS_W = 18 * MiB;
constexpr size_t W_IN = 0, W_O = 24 * MiB, W_UP = 32 * MiB, W_DN = 76 * MiB, W_LAYER = 98 * MiB;
constexpr size_t WS_R1 = WS_W + 2 * W_LAYER;
constexpr size_t R1_T = 195 * MiB;
constexpr size_t WS_R2 = WS_R1 + 358 * MiB;
constexpr size_t R2_B = 65 * MiB;
constexpr size_t WS_SLAB_O = WS_R1 + 325 * MiB, WS_SLAB_D = WS_R1 + 65 * MiB;
constexpr int KSPLIT_O = 8, KSPLIT_D = 11;
constexpr size_t WS_NATAB = WS_R2 + 179 * MiB;
constexpr int NATAB_N = 17 * 4096;
constexpr size_t WS_END = WS_NATAB + 5 * MiB;
static_assert((size_t)MT * IN_DIM * 2 <= R1_T && R1_T + (size_t)MT * DM * 4 <= 358 * MiB && (size_t)MT * NUP * 2 <= 358 * MiB && (size_t)MT * DFF * 2 <= 179 * MiB && (size_t)MT * DM * 2 <= R2_B, "ws map");

struct Params { const float* in[19]; float* out; unsigned char* ws; };
enum { I_X = 0, I_C, I_CTX, I_CCTX, I_WADA, I_BADA, I_WIN, I_LAM, I_SUBLN, I_RPB, I_WO, I_LN1G, I_LN1B, I_WUP, I_CONVW, I_CONVB, I_WDN, I_LN2G, I_LN2B };

__device__ __forceinline__ unsigned f2bf(float f) { unsigned u = __builtin_bit_cast(unsigned, f); return (u + 0x7fffu + ((u >> 16) & 1u)) >> 16; }
__device__ __forceinline__ unsigned pk2(float lo, float hi) { return f2bf(lo) | (f2bf(hi) << 16); }
__device__ __forceinline__ float bflo(unsigned w) { return __uint_as_float(w << 16); }
__device__ __forceinline__ float bfhi(unsigned w) { return __uint_as_float(w & 0xffff0000u); }
__device__ __forceinline__ float wave_sum(float v, int lane) {
#pragma unroll
    for (int o = 1; o < 64; o <<= 1) v += __builtin_bit_cast(float, __builtin_amdgcn_ds_bpermute((lane ^ o) << 2, __builtin_bit_cast(int, v)));
    return v;
}
__device__ __forceinline__ float* xrow(const Params& P, int r) { return r < LC ? (float*)(P.ws + WS_XC) + (size_t)r * DM : P.out + (size_t)(r - LC) * DM; }

__device__ __forceinline__ int rope_perm_col(int n) { const int w = n & 127, p = w >> 6, partner = (w >> 5) & 1, i = w & 31, sub = i >> 2, jj = i & 3;
    return (n & ~127) + (p * 2 + (sub >> 2)) * 32 + (sub & 3) * 8 + partner * 4 + jj; }
template <bool ROPEP> __device__ __forceinline__ void transpose_item(const float* W, int K, int N, bf16* WT, LAS float* scr, int item, int lane) {
    const int nblk = N / 32, kb = item / nblk, nb = item % nblk, k0 = 64 * kb, n0 = 32 * nb;
#pragma unroll 8
    for (int i = 0; i < 32; ++i) { const int kk = 2 * i + (lane >> 5); scr[kk * 33 + (lane & 31)] = W[(size_t)(k0 + kk) * N + n0 + (lane & 31)]; }
    asm volatile("s_waitcnt lgkmcnt(0)" ::: "memory");
    const int c = lane & 7;
#pragma unroll
    for (int j = 0; j < 4; ++j) { const int n = (lane >> 3) + 8 * j; const LAS float* s = scr + (8 * c) * 33 + n;
        v4u o; o.x = pk2(s[0 * 33], s[1 * 33]); o.y = pk2(s[2 * 33], s[3 * 33]); o.z = pk2(s[4 * 33], s[5 * 33]); o.w = pk2(s[6 * 33], s[7 * 33]);
        const int nr = (ROPEP && (n0 + n) < 2048) ? rope_perm_col(n0 + n) : (n0 + n);
        *(GAS v4u*)(WT + (size_t)nr * K + k0 + 8 * c) = o; }
    asm volatile("s_waitcnt lgkmcnt(0)" ::: "memory");
}

__device__ __forceinline__ void ph_prologue(const Params& P, unsigned char* lds, int tid, int lane, int wave, int G) {
    float* sl = (float*)lds;
    for (int i = tid; i < 2 * DM; i += 512) { const float v = i < DM ? P.in[I_C][i] : P.in[I_CCTX][i - DM]; sl[i] = v / (1.0f + __expf(-v)); }
    __syncthreads();
    float* part = (float*)(P.ws + WS_PART);
    for (int u = blockIdx.x; u < 2 * 64 * 6; u += G) {
        const int l = u / 384, rem = u % 384, kc = rem / 6, jc = rem % 6, k0 = kc * 32, j = jc * 2048 + tid * 4;
        const float* w = P.in[I_WADA] + ((size_t)l * DM + k0) * NMOD + j;
        f32x4 a0 = {0.f, 0.f, 0.f, 0.f}, a1 = {0.f, 0.f, 0.f, 0.f};
#pragma unroll 8
        for (int kk = 0; kk < 32; ++kk) { const f32x4 wv = *(const f32x4*)(w + (size_t)kk * NMOD); a0 += wv * sl[k0 + kk]; a1 += wv * sl[DM + k0 + kk]; }
        *(f32x4*)(part + ((size_t)(l * 64 + kc) * 2 + 0) * NMOD + j) = a0;
        *(f32x4*)(part + ((size_t)(l * 64 + kc) * 2 + 1) * NMOD + j) = a1;
    }
    const int gtid = blockIdx.x * 512 + tid;
    if (gtid < 320 * 32) {
        const int pos = gtid >> 5, i = gtid & 31; const float p = (float)(pos < 256 ? pos : pos - 256);
        const float inv = exp2f(-(float)(2 * i) * (13.287712379549449f / 64.0f)); const float ang = p * inv;
        const double rev = (double)ang * 0.15915494309189535; const float fr_ = (float)(rev - floor(rev));
        float* rt = (float*)(P.ws + WS_ROPE) + (size_t)gtid * 2; rt[0] = __builtin_amdgcn_cosf(fr_); rt[1] = __builtin_amdgcn_sinf(fr_);
    }
    if (blockIdx.x == 0 && wave < NLAYER) {
        const int l = wave; const float* lv = P.in[I_LAM] + (size_t)l * 4 * 128;
        const float s01 = wave_sum(lv[lane] * lv[128 + lane] + lv[64 + lane] * lv[192 + lane], lane);
        const float s23 = wave_sum(lv[256 + lane] * lv[384 + lane] + lv[320 + lane] * lv[448 + lane], lane);
        const float lam_init = 0.8f - 0.6f * expf(-0.3f * (float)l);
        if (lane == 0) { float* o = (float*)(P.ws + WS_LAMV) + 2 * l; o[0] = expf(s01) - expf(s23) + lam_init; o[1] = 1.0f - lam_init; }
    }
    {
        float* nt = (float*)(P.ws + WS_NATAB);
        for (int o = gtid; o < NLAYER * 8 * NATAB_N; o += G * 512) {
            const int lh = o / NATAB_N, rem = o % NATAB_N, slice = rem >> 12, c = (rem >> 6) & 63, kc = rem & 63;
            int cs = c - 8; cs = cs < 0 ? 0 : (cs > 48 ? 48 : cs);
            float v = 0.f;
            if (slice == 15) v = -1e30f;
            else if (slice < 15) v = (kc >= cs && kc < cs + 16) ? P.in[I_RPB][(size_t)lh * att::RPB_N + slice * 31 + (kc - c + 15)] * (1.0f / att::SCALE) : -1e30f;
            nt[o] = v;
        }
    }
    __syncthreads();
    LAS float* scr = (LAS float*)((LAS unsigned char*)lds + wave * 16384);
    const int gw = blockIdx.x * 8 + wave, NGW = G * 8;
    constexpr int I_1 = (DM / 64) * (IN_DIM / 32), I_2 = (DM / 64) * (DM / 32), I_3 = (DM / 64) * (NUP / 32), I_4 = (DFF / 64) * (DM / 32), I_L = I_1 + I_2 + I_3 + I_4;
    for (int it = gw; it < NLAYER * I_L; it += NGW) {
        const int l = it / I_L; int r = it % I_L; unsigned char* wl = P.ws + WS_W + (size_t)l * W_LAYER;
        if (r < I_1) { transpose_item<true>(P.in[I_WIN] + (size_t)l * DM * IN_DIM, DM, IN_DIM, (bf16*)(wl + W_IN), scr, r, lane); continue; } r -= I_1;
        if (r < I_2) { transpose_item<false>(P.in[I_WO] + (size_t)l * DM * DM, DM, DM, (bf16*)(wl + W_O), scr, r, lane); continue; } r -= I_2;
        if (r < I_3) { transpose_item<false>(P.in[I_WUP] + (size_t)l * DM * NUP, DM, NUP, (bf16*)(wl + W_UP), scr, r, lane); continue; } r -= I_3;
        transpose_item<false>(P.in[I_WDN] + (size_t)l * DFF * DM, DFF, DM, (bf16*)(wl + W_DN), scr, r, lane);
    }
}
__device__ __forceinline__ void ph_modreduce(const Params& P, int gtid, int NTH) {
    const float* part = (const float*)(P.ws + WS_PART); float* mod = (float*)(P.ws + WS_MOD);
    for (int o = gtid; o < NLAYER * 2 * NMOD; o += NTH) {
        const int l = o / (2 * NMOD), which = (o / NMOD) & 1, j = o % NMOD;
        float s = P.in[I_BADA][l * NMOD + j];
        for (int kc = 0; kc < 64; ++kc) s += part[((size_t)(l * 64 + kc) * 2 + which) * NMOD + j];
        mod[o] = s;
    }
}
__device__ __forceinline__ const float* modp(const Params& P, int l, int which, int k) { return (const float*)(P.ws + WS_MOD) + (size_t)(l * 2 + which) * NMOD + (size_t)k * DM; }

__device__ __forceinline__ void ph_modulate0(const Params& P, int gw, int NGW, int lane) {
    bf16* H = (bf16*)(P.ws + WS_R2);
    for (int r0 = gw; r0 < MT; r0 += 2 * NGW) {
        f32x4 xv[2][8];
#pragma unroll
        for (int q = 0; q < 2; ++q) { const int r = r0 + q * NGW; if (r < MT) { const float* src = r < LC ? P.in[I_CTX] + (size_t)r * DM : P.in[I_X] + (size_t)(r - LC) * DM;
#pragma unroll
            for (int j = 0; j < 8; ++j) xv[q][j] = *(const f32x4*)(src + 4 * lane + 256 * j); } }
#pragma unroll
        for (int q = 0; q < 2; ++q) { const int r = r0 + q * NGW; if (r < MT) { const int which = r < LC; const float* sh = modp(P, 0, which, 0); const float* sc = modp(P, 0, which, 1);
#pragma unroll
            for (int j = 0; j < 8; ++j) { const int col = 4 * lane + 256 * j; const f32x4 s = *(const f32x4*)(sc + col), t = *(const f32x4*)(sh + col);
                const f32x4 o = xv[q][j] * (s + 1.0f) + t; v2u w; w.x = pk2(o[0], o[1]); w.y = pk2(o[2], o[3]); *(v2u*)(H + (size_t)r * DM + col) = w; } } }
    }
}
__device__ __forceinline__ void ph_rope(const Params& P, int gw, int NGW, int lane) {
    bf16* proj = (bf16*)(P.ws + WS_R1); const float* tab = (const float*)(P.ws + WS_ROPE);
    for (int r0 = LC + gw; r0 < MT; r0 += 2 * NGW) {
        v4u a[2][2], bq[2][2];
#pragma unroll
        for (int q = 0; q < 2; ++q) { const int r = r0 + q * NGW; if (r < MT) { bf16* row = proj + (size_t)r * IN_DIM;
#pragma unroll
            for (int k = 0; k < 2; ++k) { const int unit = lane + 64 * k, b = unit >> 3, p = (unit >> 2) & 1, i0 = (unit & 3) * 8; const bf16* p1 = row + b * 128 + p * 64 + i0;
                a[q][k] = *(const v4u*)p1; bq[q][k] = *(const v4u*)(p1 + 32); } } }
#pragma unroll
        for (int q = 0; q < 2; ++q) { const int r = r0 + q * NGW; if (r < MT) { const int t = r - LC, pr = t >> 6, pc = t & 63; bf16* row = proj + (size_t)r * IN_DIM;
#pragma unroll
            for (int k = 0; k < 2; ++k) {
                const int unit = lane + 64 * k, b = unit >> 3, p = (unit >> 2) & 1, i0 = (unit & 3) * 8; bf16* p1 = row + b * 128 + p * 64 + i0;
                const float* tb = tab + ((size_t)(p ? 256 + pc : pr) * 32 + i0) * 2; v4u oa, ob;
#pragma unroll
                for (int e = 0; e < 4; ++e) {
                    const f32x4 cs = *(const f32x4*)(tb + 4 * e);
                    const float x1l = bflo(a[q][k][e]), x1h = bfhi(a[q][k][e]), x2l = bflo(bq[q][k][e]), x2h = bfhi(bq[q][k][e]);
                    oa[e] = pk2(x1l * cs[0] - x2l * cs[1], x1h * cs[2] - x2h * cs[3]);
                    ob[e] = pk2(x2l * cs[0] + x1l * cs[1], x2h * cs[2] + x1h * cs[3]);
                }
                *(v4u*)p1 = oa; *(v4u*)(p1 + 32) = ob;
            } } }
    }
}
__device__ __forceinline__ void ph_combine(const Params& P, int l, int gw, int NGW, int lane) {
    const float* T = (const float*)(P.ws + WS_R1 + R1_T); bf16* AO = (bf16*)(P.ws + WS_R2 + R2_B);
    const float lam = ((const float*)(P.ws + WS_LAMV))[2 * l], osc = ((const float*)(P.ws + WS_LAMV))[2 * l + 1];
    const f32x4 g = *(const f32x4*)(P.in[I_SUBLN] + (size_t)l * 256 + 4 * lane);
    const int r_lo = (l == NLAYER - 1) ? LC : 0;
    for (int r = r_lo + gw; r < MT; r += NGW) {
        f32x4 o1[4], o2[4];
#pragma unroll
        for (int h = 0; h < 4; ++h) { o1[h] = *(const f32x4*)(T + (size_t)r * DM + h * 512 + 4 * lane); o2[h] = *(const f32x4*)(T + (size_t)r * DM + h * 512 + 256 + 4 * lane); }
#pragma unroll
        for (int h = 0; h < 4; ++h) {
            const f32x4 d = o1[h] - o2[h] * lam;
            const float ss = wave_sum(d[0] * d[0] + d[1] * d[1] + d[2] * d[2] + d[3] * d[3], lane);
            const float rinv = 1.0f / sqrtf(ss * (1.0f / 256.0f) + LN_EPS);
            const f32x4 o = d * rinv * g * osc;
            v2u w; w.x = pk2(o[0], o[1]); w.y = pk2(o[2], o[3]); *(v2u*)(AO + (size_t)r * DM + h * 256 + 4 * lane) = w;
        }
    }
}
__device__ __forceinline__ void ph_ln(const Params& P, int l, int stage, unsigned char* lds, int tid, int gw, int NGW, int lane) {
    const bool last = (l == NLAYER - 1);
    const bf16* ADD = stage == 1 ? (const bf16*)(P.ws + WS_R2) : (const bf16*)(P.ws + WS_R1);
    bf16* HN = stage == 1 ? (bf16*)(P.ws + WS_R2 + R2_B) : (bf16*)(P.ws + WS_R2);
    const float* lg = (stage == 1 ? P.in[I_LN1G] : P.in[I_LN2G]) + (size_t)l * DM; const float* lb = (stage == 1 ? P.in[I_LN1B] : P.in[I_LN2B]) + (size_t)l * DM;
    const float* SLAB = (const float*)(P.ws + (stage == 1 ? WS_SLAB_O : WS_SLAB_D));
    const bool write_h = (stage == 1) || !last;
    const int r_lo = last ? LC : 0, lsc = stage == 1 ? l : (last ? l : l + 1);
    float* V = (float*)lds;
    for (int i = tid; i < 8 * DM; i += 512) {
        const int k = i / DM, c = i % DM; float v;
        if (k == 3) v = lg[c]; else if (k == 4) v = lb[c];
        else { const int which = k >= 5, kk = which ? k - 5 : k;
            v = kk == 0 ? modp(P, l, which, stage == 1 ? 2 : 5)[c] : (kk == 1 ? modp(P, lsc, which, stage == 1 ? 4 : 1)[c] : modp(P, lsc, which, stage == 1 ? 3 : 0)[c]); }
        V[i] = v;
    }
    __syncthreads();
    f32x4 xa[8]; v2u ya[8];
#define LN_LOAD(rr, X, Y) do { const float* xin_ = (stage == 1 && l == 0) ? ((rr) < LC ? P.in[I_CTX] + (size_t)(rr) * DM : P.in[I_X] + (size_t)((rr) - LC) * DM) : xrow(P, (rr)); const bf16* ad_ = ADD + (size_t)(rr) * DM; \
        _Pragma("unroll") for (int j = 0; j < 8; ++j) { const int col_ = 4 * lane + 256 * j; X[j] = *(const f32x4*)(xin_ + col_); \
            if (l == 0 && (rr) < LC) { const float* sp_ = SLAB + (size_t)(rr) * DM + col_; f32x4 a_ = *(const f32x4*)sp_; _Pragma("unroll") for (int s_ = 1; s_ < KSPLIT_D; ++s_) if (s_ < (stage == 1 ? KSPLIT_O : KSPLIT_D)) a_ += *(const f32x4*)(sp_ + (size_t)s_ * 256 * DM); \
                v2u w_; w_.x = pk2(a_[0], a_[1]); w_.y = pk2(a_[2], a_[3]); Y[j] = w_; } else Y[j] = *(const v2u*)(ad_ + col_); } } while (0)
    int r = r_lo + gw;
    if (r < MT) LN_LOAD(r, xa, ya);
    while (r < MT) {
        const int rn = r + NGW; f32x4 xb[8]; v2u yb[8];
#pragma unroll
        for (int j = 0; j < 8; ++j) { xb[j] = (f32x4){0.f, 0.f, 0.f, 0.f}; yb[j] = (v2u){0u, 0u}; }
        if (rn < MT) LN_LOAD(rn, xb, yb);
        const int which = r < LC; const float* gt = V + (which ? 5 : 0) * DM; const float* scv = V + (which ? 6 : 1) * DM; const float* shv = V + (which ? 7 : 2) * DM;
        float* xo = xrow(P, r);
        f32x4 v[8]; float s = 0.f;
#pragma unroll
        for (int j = 0; j < 8; ++j) { const int col = 4 * lane + 256 * j; const f32x4 g4 = *(const f32x4*)(gt + col);
            const f32x4 a = {bflo(ya[j].x), bfhi(ya[j].x), bflo(ya[j].y), bfhi(ya[j].y)};
            v[j] = xa[j] * ALPHA + g4 * a; s += (v[j][0] + v[j][1]) + (v[j][2] + v[j][3]); }
        const float mean = wave_sum(s, lane) * (1.0f / DM); float s2 = 0.f;
#pragma unroll
        for (int j = 0; j < 8; ++j) { v[j] = v[j] - mean; s2 += (v[j][0] * v[j][0] + v[j][1] * v[j][1]) + (v[j][2] * v[j][2] + v[j][3] * v[j][3]); }
        const float rstd = 1.0f / sqrtf(wave_sum(s2, lane) * (1.0f / DM) + LN_EPS);
#pragma unroll
        for (int j = 0; j < 8; ++j) { const int col = 4 * lane + 256 * j; const f32x4 gg = *(const f32x4*)(V + 3 * DM + col), bb = *(const f32x4*)(V + 4 * DM + col);
            const f32x4 o = v[j] * rstd * gg + bb; *(f32x4*)(xo + col) = o;
            if (write_h) { const f32x4 s4 = *(const f32x4*)(scv + col), t4 = *(const f32x4*)(shv + col); const f32x4 hv = o * (s4 + 1.0f) + t4;
                v2u w; w.x = pk2(hv[0], hv[1]); w.y = pk2(hv[2], hv[3]); *(v2u*)(HN + (size_t)r * DM + col) = w; } }
#pragma unroll
        for (int j = 0; j < 8; ++j) { xa[j] = xb[j]; ya[j] = yb[j]; }
        r = rn;
    }
#undef LN_LOAD
    __syncthreads();
}
__device__ __forceinline__ void ph_conv(const Params& P, int l, int gtid, int NTH) {
    const bf16* UP = (const bf16*)(P.ws + WS_R1); bf16* ACT = (bf16*)(P.ws + WS_R2);
    const float* cw = P.in[I_CONVW] + (size_t)l * 3 * DFF; const float* cb = P.in[I_CONVB] + (size_t)l * DFF;
    constexpr int NCG = DFF / 8, RS = 16, NSTRIP = MT / RS;
    const int s_lo = (l == NLAYER - 1) ? LC / RS : 0;
    const int nsl = NTH / NCG;
    if (gtid >= nsl * NCG) return;
    const int cgi = gtid % NCG, ch = cgi * 8;
    float w0[8], w1[8], w2[8], bb[8];
#pragma unroll
    for (int e = 0; e < 8; ++e) { w0[e] = cw[ch + e]; w1[e] = cw[DFF + ch + e]; w2[e] = cw[2 * DFF + ch + e]; bb[e] = cb[ch + e]; }
    for (int strip = s_lo + gtid / NCG; strip < NSTRIP; strip += nsl) {
        const int r0 = strip * RS;
        const bool hasprev = (r0 != 0) && (r0 != LC), hasnext = (r0 + RS != LC) && (r0 + RS != MT);
        v4u g[RS + 2], u[RS];
        g[0] = (v4u){0u, 0u, 0u, 0u}; g[RS + 1] = (v4u){0u, 0u, 0u, 0u};
        if (hasprev) g[0] = *(const v4u*)(UP + (size_t)(r0 - 1) * NUP + ch);
#pragma unroll
        for (int i = 0; i < RS; ++i) { g[i + 1] = *(const v4u*)(UP + (size_t)(r0 + i) * NUP + ch); u[i] = *(const v4u*)(UP + (size_t)(r0 + i) * NUP + DFF + ch); }
        if (hasnext) g[RS + 1] = *(const v4u*)(UP + (size_t)(r0 + RS) * NUP + ch);
#pragma unroll
        for (int i = 0; i < RS; ++i) { v4u o;
#pragma unroll
            for (int e = 0; e < 4; ++e) {
                const float ga = bflo(g[i][e]) * w0[2 * e] + bflo(g[i + 1][e]) * w1[2 * e] + bflo(g[i + 2][e]) * w2[2 * e] + bb[2 * e];
                const float gb = bfhi(g[i][e]) * w0[2 * e + 1] + bfhi(g[i + 1][e]) * w1[2 * e + 1] + bfhi(g[i + 2][e]) * w2[2 * e + 1] + bb[2 * e + 1];
                const float sa = ga / (1.0f + __expf(-ga)), sb = gb / (1.0f + __expf(-gb));
                o[e] = pk2(sa * bflo(u[i][e]), sb * bfhi(u[i][e]));
            }
            *(v4u*)(ACT + (size_t)(r0 + i) * DFF + ch) = o; }
    }
}
__device__ __forceinline__ void ph_attn(const Params& P, int l, unsigned char* lds, int vcu, int G) {
    const bf16* proj = (const bf16*)(P.ws + WS_R1); float* T = (float*)(P.ws + WS_R1 + R1_T); bf16* AO = (bf16*)(P.ws + WS_R2 + R2_B);
    const int n_units = 512 + 512 + (l == 0 ? 16 : 0);
#pragma unroll 1
    for (int u = vcu; u < n_units; u += G) {
        att::Unit U;
        U.Of = nullptr; U.Ob = nullptr; U.natab = nullptr; U.na = 0; U.qrow0 = 0; U.kr0 = 0; U.base1 = 0;
        int kind = 0;
        if (u < 512) {
            const int hc = u >> 6, qb = u & 63, h = hc >> 1, c = hc & 1; const size_t q0 = (size_t)(LC + qb * 256);
            U.Q = proj + q0 * IN_DIM + h * 256 + c * 128; U.K = proj + 1024 + h * 256 + c * 128; U.V = proj + 2048 + h * 256;
            U.Of = T + q0 * DM + h * 512 + c * 256; U.nt = MT / 64; U.nsplit = MT / 64;
        } else if (u < 1024) {
            const int un = u - 512, h = un >> 6, qb = un & 63; const size_t q0 = (size_t)(LC + qb * 256);
            int start = 4 * qb - 4; start = start < 0 ? 0 : (start > 244 ? 244 : start);
            U.Q = proj + q0 * IN_DIM + 3072 + h * 128; U.K = proj + 4096 + h * 128; U.V = proj + 5120 + h * 128;
            U.Ob = AO + q0 * DM + 1024 + h * 128; U.nt = 16; U.nsplit = 4; U.base1 = LC + start * 64; U.na = 1; U.qrow0 = 4 * qb; U.kr0 = start;
            U.natab = (const float*)(P.ws + WS_NATAB) + (size_t)(l * 8 + h) * NATAB_N; kind = 2;
        } else {
            const int v = u - 1024;
            if (v < 8) { const int h = v >> 1, c = v & 1;
                U.Q = proj + h * 256 + c * 128; U.K = proj + 1024 + h * 256 + c * 128; U.V = proj + 2048 + h * 256; U.Of = T + h * 512 + c * 256; }
            else { const int h = v - 8; U.Q = proj + 3072 + h * 128; U.K = proj + 4096 + h * 128; U.V = proj + 5120 + h * 128; U.Ob = AO + 1024 + h * 128; kind = 1; }
            U.nt = 4; U.nsplit = 4;
        }
        if (kind == 0) att::unit_body_da(U, (char*)lds); else if (kind == 2) att::unit_body_v128<true>(U, (char*)lds); else att::unit_body_v128<false>(U, (char*)lds);
    }
}

#define XB_TMO      128
#define XB_XCNT(j)  (256  + 64 * (j))
#define XB_XSUB(j)  (1280 + 64 * (j))
#define XB_XGEN(j)  (2304 + 64 * (j))
#define XB_TOP      3328
#define XB_TOPGEN   3392
#define XCD_BAR_WORDS 3456
#define XB_SPIN_CAP (1u << 18)

__device__ __forceinline__ unsigned xb_ld(unsigned* p)              { return __hip_atomic_load(p, __ATOMIC_RELAXED, __HIP_MEMORY_SCOPE_AGENT); }
__device__ __forceinline__ unsigned xb_add(unsigned* p, unsigned v) { return __hip_atomic_fetch_add(p, v, __ATOMIC_RELAXED, __HIP_MEMORY_SCOPE_AGENT); }
__device__ __forceinline__ unsigned xb_xcc_id() { return (unsigned)__builtin_amdgcn_s_getreg((3 << 11) | 20) & 0xFu; }
#define XB_SPIN(cond, bar) do { unsigned _sp = 0; while (cond) { __builtin_amdgcn_s_sleep(1); \
    if ((++_sp & 255u) == 0u) { if (xb_ld(&(bar)[XB_TMO])) break; if (_sp > XB_SPIN_CAP) { atomicAdd(&(bar)[XB_TMO], 1u); break; } } } } while (0)

struct XcdBarrier {
    unsigned* bar; unsigned x;
    volatile LAS unsigned* st;
};

__device__ __forceinline__ XcdBarrier xcd_barrier_post(unsigned* bar, volatile LAS unsigned* st) {
    XcdBarrier b; b.bar = bar; b.x = xb_xcc_id(); b.st = st;
    if (threadIdx.x == 0) (void)xb_add(&bar[XB_XCNT(b.x)], 1u);
    return b;
}
__device__ __forceinline__ void xcd_barrier_complete(unsigned* bar, unsigned x, unsigned& nloc, unsigned& nx) {
    const unsigned G = gridDim.x * gridDim.y * gridDim.z;
    unsigned sum, cnt, mine, sp = 0u;
    for (;;) {
        sum = 0u; cnt = 0u; mine = 0u;
#pragma unroll
        for (unsigned j = 0; j < 16; ++j) { const unsigned c = xb_ld(&bar[XB_XCNT(j)]); sum += c; cnt += (c > 0u) ? 1u : 0u; mine = (j == x) ? c : mine; }
        if (sum == G) break;
        __builtin_amdgcn_s_sleep(1);
        if ((++sp & 255u) == 0u) { if (xb_ld(&bar[XB_TMO])) break; if (sp > XB_SPIN_CAP) { atomicAdd(&bar[XB_TMO], 1u); break; } }
    }
    nloc = mine > 0u ? mine : 1u; nx = cnt > 0u ? cnt : 1u;
}

__device__ __forceinline__ void xcd_barrier(const XcdBarrier& b) {
    asm volatile("s_waitcnt vmcnt(0)" ::: "memory");
    __syncthreads();
    if (threadIdx.x == 0) {
        unsigned* bar = b.bar;
        __builtin_amdgcn_s_waitcnt(0);
        unsigned nloc = b.st[0], nx = b.st[1];
        if (nloc == 0u) { xcd_barrier_complete(bar, b.x, nloc, nx); b.st[0] = nloc; b.st[1] = nx; }
        const unsigned old = xb_add(&bar[XB_XSUB(b.x)], 1u);
        const unsigned gen = old / nloc;
        if (old + 1u == (gen + 1u) * nloc) {
            __builtin_amdgcn_fence(__ATOMIC_RELEASE, "agent");
            asm volatile("s_waitcnt vmcnt(0)" ::: "memory");
            const unsigned og = xb_add(&bar[XB_TOP], 1u);
            const unsigned tg = og / nx;
            if (og + 1u == (tg + 1u) * nx) xb_add(&bar[XB_TOPGEN], 1u);
            else XB_SPIN(xb_ld(&bar[XB_TOPGEN]) == tg, bar);
            __builtin_amdgcn_fence(__ATOMIC_ACQUIRE, "agent");
            xb_add(&bar[XB_XGEN(b.x)], 1u);
            asm volatile("s_waitcnt vmcnt(0)" ::: "memory");
        } else {
            XB_SPIN(xb_ld(&bar[XB_XGEN(b.x)]) == gen, bar);
            __builtin_amdgcn_fence(__ATOMIC_ACQUIRE, "agent");
            asm volatile("s_waitcnt vmcnt(0)" ::: "memory");
        }
    }
    __syncthreads();
}
constexpr int LDS_BYTES = 135168;
static_assert(att::SHM_ATTN <= 131072 && att::SHM_DA <= 131072 && pg8::STAGE_BYTES == 131072, "LDS map");

constexpr int NPHASES = 3 + NLAYER * 9;
__global__ void __launch_bounds__(512) mega_fwd(Params P) {
    extern __shared__ __attribute__((aligned(16))) unsigned char lds[];
    cg::grid_group grid = cg::this_grid();
    { volatile LAS unsigned* st_ = (volatile LAS unsigned*)((LAS unsigned char*)lds + 131072); if (threadIdx.x < 16) st_[threadIdx.x] = 0u; }
    __syncthreads();
    const XcdBarrier xbar = xcd_barrier_post((unsigned*)(P.ws + WS_BAR), (volatile LAS unsigned*)((LAS unsigned char*)lds + 131072));
    const int G = gridDim.x, bx = blockIdx.x;
#define VCU ((G % 8 == 0) ? (bx % 8) * (G / 8) + bx / 8 : bx)
    int ph = 0;
#define NGW (G * 8)
#define NTH (G * 512)
#define RUN(body) do { { int tid = threadIdx.x; asm volatile("" : "+v"(tid)); const int lane = tid & 63, wave = __builtin_amdgcn_readfirstlane(tid >> 6), gw = bx * 8 + wave, gtid = bx * 512 + tid; (void)lane; (void)gw; (void)gtid; body; } if (ph + 1 < NPHASES) { if (G < 0) grid.sync(); else xcd_barrier(xbar); } ++ph; } while (0)
#define GEMM(Aptr, Wptr, Optr, M_, N_, K_) do { pg8::Gemm g{(const pg8::bf16_t*)(Aptr), (const pg8::bf16_t*)(Wptr), (M_), (N_), (K_), (K_)}; pg8::StaticOrder S; S.init((M_), (N_), G, bx); \
        pg8::EpiBf16 E{(pg8::bf16_t*)(Optr), (N_)}; pg8::gemm_phase<pg8::EpiBf16, pg8::StaticOrder, true, true>((PG8_LAS unsigned char*)lds, g, S, E); } while (0)
      \
#define GEMM_CTX(Aptr, Wptr, SLAB, N_, K_, S_) do { const int nun_ = ((N_) / 256) * (S_); const bool has_ = bx < nun_; const int pn_ = has_ ? bx / (S_) : 0, sp_ = has_ ? bx % (S_) : 0; constexpr int Kc_ = (K_) / (S_); \
        pg8::Gemm g{(const pg8::bf16_t*)(Aptr) + sp_ * Kc_, (const pg8::bf16_t*)(Wptr) + sp_ * Kc_, 256, (N_), Kc_, (K_)}; pg8::OneUnit S{pn_, has_}; \
        pg8::EpiF32 E{(float*)(SLAB), (N_), sp_}; pg8::gemm_phase<pg8::EpiF32, pg8::OneUnit, false, true>((PG8_LAS unsigned char*)lds, g, S, E); } while (0)
#define GEMM_PROJ(Aptr, Wptr, Optr) do { pg8::Gemm g{(const pg8::bf16_t*)(Aptr), (const pg8::bf16_t*)(Wptr), MT, IN_DIM, DM, DM}; pg8::StaticOrder S; S.init(MT, IN_DIM, G, bx); \
        pg8::EpiProj E{(pg8::bf16_t*)(Optr), IN_DIM, (const float*)(P.ws + WS_ROPE)}; pg8::gemm_phase<pg8::EpiProj, pg8::StaticOrder, true, true>((PG8_LAS unsigned char*)lds, g, S, E); } while (0)
#ifndef SKIP_PRO
    RUN(ph_prologue(P, lds, tid, lane, wave, G));
#endif
    RUN(ph_modreduce(P, gtid, NTH));
    RUN(ph_modulate0(P, gw, NGW, lane));
    {
        constexpr int l = 0; constexpr bool last = (l == NLAYER - 1);
        constexpr size_t ro = LC;
        const size_t ru = last ? (size_t)LC : 0; const int Mu = last ? SEQL : MT;
#define wl (P.ws + WS_W + (size_t)l * W_LAYER)
        RUN(GEMM_PROJ(P.ws + WS_R2, wl + W_IN, P.ws + WS_R1));
        RUN(ph_attn(P, l, lds, VCU, G));
        RUN(ph_combine(P, l, gw, NGW, lane));
        RUN(GEMM(P.ws + WS_R2 + R2_B + ro * DM * 2, wl + W_O, P.ws + WS_R2 + ro * DM * 2, SEQL, DM, DM); if (!last) GEMM_CTX(P.ws + WS_R2 + R2_B, wl + W_O, P.ws + WS_SLAB_O, DM, DM, KSPLIT_O));
        RUN(ph_ln(P, l, 1, lds, tid, gw, NGW, lane));
        RUN(GEMM(P.ws + WS_R2 + R2_B + ru * DM * 2, wl + W_UP, P.ws + WS_R1 + ru * NUP * 2, Mu, NUP, DM));
        RUN(ph_conv(P, l, gtid, NTH));
        RUN(GEMM(P.ws + WS_R2 + ro * DFF * 2, wl + W_DN, P.ws + WS_R1 + ro * DM * 2, SEQL, DM, DFF); if (!last) GEMM_CTX(P.ws + WS_R2, wl + W_DN, P.ws + WS_SLAB_D, DM, DFF, KSPLIT_D));
        RUN(ph_ln(P, l, 2, lds, tid, gw, NGW, lane));
    }
    {
        constexpr int l = 1; constexpr bool last = (l == NLAYER - 1);
        constexpr size_t ro = LC;
        const size_t ru = last ? (size_t)LC : 0; const int Mu = last ? SEQL : MT;
        RUN(GEMM_PROJ(P.ws + WS_R2, wl + W_IN, P.ws + WS_R1));
        RUN(ph_attn(P, l, lds, VCU, G));
        RUN(ph_combine(P, l, gw, NGW, lane));
        RUN(GEMM(P.ws + WS_R2 + R2_B + ro * DM * 2, wl + W_O, P.ws + WS_R2 + ro * DM * 2, SEQL, DM, DM); if (!last) GEMM_CTX(P.ws + WS_R2 + R2_B, wl + W_O, P.ws + WS_SLAB_O, DM, DM, KSPLIT_O));
        RUN(ph_ln(P, l, 1, lds, tid, gw, NGW, lane));
        RUN(GEMM(P.ws + WS_R2 + R2_B + ru * DM * 2, wl + W_UP, P.ws + WS_R1 + ru * NUP * 2, Mu, NUP, DM));
        RUN(ph_conv(P, l, gtid, NTH));
        RUN(GEMM(P.ws + WS_R2 + ro * DFF * 2, wl + W_DN, P.ws + WS_R1 + ro * DM * 2, SEQL, DM, DFF); if (!last) GEMM_CTX(P.ws + WS_R2, wl + W_DN, P.ws + WS_SLAB_D, DM, DFF, KSPLIT_D));
        RUN(ph_ln(P, l, 2, lds, tid, gw, NGW, lane));
    }
#undef RUN
#undef wl
#undef GEMM
#undef GEMM_PROJ
#undef VCU
#undef NGW
#undef NTH
}

extern "C" void kernel_launch(void* const* d_in, const int* in_sizes, int n_in, void* d_out, int out_size, void* d_ws, size_t ws_size, hipStream_t stream) {
    static int grid = 0;
    if (grid == 0) {
        if (n_in != 19 || in_sizes[0] != SEQL * DM || out_size != SEQL * DM || ws_size < WS_END) { fprintf(stderr, "kernel_launch: shape/workspace mismatch (n_in %d, ws %zu < %zu)\n", n_in, ws_size, (size_t)WS_END); grid = -1; return; }
        int dev = 0, cus = 0, per_cu = 0;
        if (hipGetDevice(&dev) != hipSuccess || hipDeviceGetAttribute(&cus, hipDeviceAttributeMultiprocessorCount, dev) != hipSuccess) { grid = -1; return; }
        if (hipFuncSetAttribute((const void*)mega_fwd, hipFuncAttributeMaxDynamicSharedMemorySize, LDS_BYTES) != hipSuccess) { fprintf(stderr, "kernel_launch: hipFuncSetAttribute failed\n"); grid = -1; return; }
        if (hipOccupancyMaxActiveBlocksPerMultiprocessor(&per_cu, (const void*)mega_fwd, 512, LDS_BYTES) != hipSuccess || per_cu < 1) { fprintf(stderr, "kernel_launch: occupancy query says %d\n", per_cu); per_cu = 1; }
        (void)hipGetLastError();
        grid = cus * 1;
    }
    if (grid < 0) return;
    if (hipMemsetAsync((char*)d_ws + WS_BAR, 0, 16384 + 8 * 64 * 4, stream) != hipSuccess) { fprintf(stderr, "kernel_launch: memset failed\n"); return; }
    Params p{};
    for (int i = 0; i < 19; ++i) p.in[i] = (const float*)d_in[i];
    p.out = (float*)d_out; p.ws = (unsigned char*)d_ws;
    void* args[] = {&p};
    hipError_t e = hipLaunchCooperativeKernel((const void*)mega_fwd, dim3(grid), dim3(512), args, LDS_BYTES, stream);
    if (e != hipSuccess) fprintf(stderr, "kernel_launch: cooperative launch failed: %s (grid %d)\n", hipGetErrorString(e), grid);
}
```
